# Optimizing an MI355X kernel written in HIP

```python
import math
import jax, jax.numpy as jnp
from jax import lax
import numpy as np

D_MODEL = 2048
BATCH = 16
SEQ = 256
DEPTH = 2
DEC_BATCH = 8
DEC_SEQ = 4096
PAST_LEN = 512

GRID_W = 64
NORM_EPS = 1e-6
F_FLOOR = 1e-30
N_BRANCHES = 4
FOURIER_WIDTH = 512
FOURIER_GROUPS = 4
FOURIER_GROUP_DIM = FOURIER_WIDTH // FOURIER_GROUPS
S5_WIDTH = 512
S5_GROUP_DIM = 16
S5_GROUPS = S5_WIDTH // S5_GROUP_DIM
S5_STATE = 64
N_HEADS = 8
N_KV_HEADS = 2
HEAD_DIM = 128
Q_PER_KV = N_HEADS // N_KV_HEADS
ATTN_WIDTH = N_HEADS * HEAD_DIM
KV_WIDTH = N_KV_HEADS * HEAD_DIM
ROPE_THETA = 10000.0
Q_BLOCK = 128
HGRN_HEADS = 4
HGRN_DK = 128
HGRN_DV = 128
HGRN_WIDTH = HGRN_HEADS * HGRN_DK
HGRN_VWIDTH = HGRN_HEADS * HGRN_DV
HGRN_CHUNK = 64

IN_SIZES = (FOURIER_WIDTH, FOURIER_WIDTH,
            S5_WIDTH, S5_WIDTH,
            ATTN_WIDTH, KV_WIDTH, KV_WIDTH, ATTN_WIDTH,
            HGRN_WIDTH, HGRN_VWIDTH, HGRN_WIDTH, HGRN_WIDTH, HGRN_VWIDTH,
            N_BRANCHES * D_MODEL)
IN_COLS = sum(IN_SIZES)

kernel_name = 'hybrid_diffusion_gated_branch_step'


def rmsnorm(x, g):
    x32 = x.astype(jnp.float32)
    y = x32 * lax.rsqrt(jnp.mean(x32 * x32, axis=-1, keepdims=True) + NORM_EPS)
    return (y * g.astype(jnp.float32)).astype(x.dtype)


def split_cols(proj):
    idx = [int(v) for v in np.cumsum(IN_SIZES)[:-1]]
    return jnp.split(proj, idx, axis=-1)


def fourier_mix(u, w):
    b, l, _ = u.shape
    ug = u.astype(jnp.float32).reshape(b, l, FOURIER_GROUPS, FOURIER_GROUP_DIM)
    f = jnp.fft.fftn(ug, axes=(1, 3), norm='ortho').real
    y = jnp.einsum('blgc,gcd->blgd', f, w.astype(jnp.float32))
    return y.reshape(b, l, FOURIER_WIDTH).astype(u.dtype)


def s5_discretize(lam_re, lam_im, log_step, b_re, b_im):
    lam_re = lam_re.astype(jnp.float32)
    lam_im = lam_im.astype(jnp.float32)
    step = jnp.exp(log_step.astype(jnp.float32))[:, None]
    mag = jnp.exp(lam_re * step)
    lb_re = mag * jnp.cos(lam_im * step)
    lb_im = mag * jnp.sin(lam_im * step)
    nr = lb_re - 1.0
    den = lam_re * lam_re + lam_im * lam_im
    fr = (nr * lam_re + lb_im * lam_im) / den
    fi = (lb_im * lam_re - nr * lam_im) / den
    b_re = b_re.astype(jnp.float32)
    b_im = b_im.astype(jnp.float32)
    bb_re = fr[..., None] * b_re - fi[..., None] * b_im
    bb_im = fr[..., None] * b_im + fi[..., None] * b_re
    return lb_re, lb_im, bb_re, bb_im


def s5_combine(e1, e2):
    a1r, a1i, b1r, b1i = e1
    a2r, a2i, b2r, b2i = e2
    return (a2r * a1r - a2i * a1i,
            a2r * a1i + a2i * a1r,
            a2r * b1r - a2i * b1i + b2r,
            a2r * b1i + a2i * b1r + b2i)


def s5_scan(u, lb_re, lb_im, bb_re, bb_im, c_re, c_im, h0_re, h0_im):
    bu_re = jnp.einsum('blgp,gnp->blgn', u, bb_re)
    bu_im = jnp.einsum('blgp,gnp->blgn', u, bb_im)
    bu_re = bu_re.at[:, 0].add(lb_re * h0_re - lb_im * h0_im)
    bu_im = bu_im.at[:, 0].add(lb_re * h0_im + lb_im * h0_re)
    a_re = jnp.broadcast_to(lb_re, bu_re.shape)
    a_im = jnp.broadcast_to(lb_im, bu_im.shape)
    _, _, h_re, h_im = lax.associative_scan(s5_combine, (a_re, a_im, bu_re, bu_im), axis=1)
    c_re = c_re.astype(jnp.float32)
    c_im = c_im.astype(jnp.float32)
    y = jnp.einsum('blgn,gpn->blgp', h_re, c_re) - jnp.einsum('blgn,gpn->blgp', h_im, c_im)
    return y, h_re[:, -1], h_im[:, -1]


def s5_branch(u, p, h0_re, h0_im):
    b, l, _ = u.shape
    u32 = u.astype(jnp.float32).reshape(b, l, S5_GROUPS, S5_GROUP_DIM)
    ys, fin_re, fin_im = [], [], []
    for d in range(2):
        lb_re, lb_im, bb_re, bb_im = s5_discretize(p['s5_lambda_re'][d], p['s5_lambda_im'][d],
                                                   p['s5_log_step'][d], p['s5_b_re'][d], p['s5_b_im'][d])
        ud = u32 if d == 0 else jnp.flip(u32, axis=1)
        yd, hr, hi = s5_scan(ud, lb_re, lb_im, bb_re, bb_im, p['s5_c_re'][d], p['s5_c_im'][d],
                             h0_re[:, d].astype(jnp.float32), h0_im[:, d].astype(jnp.float32))
        ys.append(yd if d == 0 else jnp.flip(yd, axis=1))
        fin_re.append(hr)
        fin_im.append(hi)
    dskip = p['s5_d'].astype(jnp.float32).reshape(S5_GROUPS, S5_GROUP_DIM)
    y = (ys[0] + ys[1] + dskip * u32).reshape(b, l, S5_WIDTH)
    y = jax.nn.gelu(y)
    y = y * jax.nn.sigmoid(y @ p['s5_glu_w'].astype(jnp.float32) + p['s5_glu_b'].astype(jnp.float32))
    return y.astype(u.dtype), jnp.stack(fin_re, axis=1), jnp.stack(fin_im, axis=1)


def attention_heads(q, k, v, q_norm, k_norm):
    b, l, _ = q.shape
    q = rmsnorm(q.reshape(b, l, N_KV_HEADS, Q_PER_KV, HEAD_DIM), q_norm)
    k = rmsnorm(k.reshape(b, l, N_KV_HEADS, HEAD_DIM), k_norm)
    v = v.reshape(b, l, N_KV_HEADS, HEAD_DIM)
    return q, k, v


def axial_angles(l):
    rows = l // GRID_W
    row = jnp.broadcast_to(jnp.arange(rows, dtype=jnp.float32)[:, None], (rows, GRID_W)).reshape(-1)
    col = jnp.broadcast_to(jnp.arange(GRID_W, dtype=jnp.float32)[None, :], (rows, GRID_W)).reshape(-1)
    half = HEAD_DIM // 2
    inv = ROPE_THETA ** (-jnp.arange(0, half, 2, dtype=jnp.float32) / half)
    return jnp.stack([row[:, None] * inv, col[:, None] * inv], axis=1)


def apply_axial_rope(x, ang):
    l = x.shape[1]
    xr = x.astype(jnp.float32).reshape(x.shape[:-1] + (2, 2, HEAD_DIM // 4))
    a = ang.reshape((l,) + (1,) * (x.ndim - 3) + (2, HEAD_DIM // 4))
    cos, sin = jnp.cos(a), jnp.sin(a)
    x1, x2 = xr[..., 0, :], xr[..., 1, :]
    out = jnp.stack([x1 * cos - x2 * sin, x2 * cos + x1 * sin], axis=-2)
    return out.reshape(x.shape).astype(x.dtype)


def block_attention(q, k, v):
    b, lq, hkv, g, hd = q.shape
    nb = lq // Q_BLOCK
    qb = q.reshape(b, nb, Q_BLOCK, hkv, g, hd).transpose(1, 0, 2, 3, 4, 5)
    scale = HEAD_DIM ** -0.5

    def one_block(qblk):
        s = jnp.einsum('bqhgd,bkhd->bhgqk', qblk, k).astype(jnp.float32) * scale
        pr = jax.nn.softmax(s, axis=-1).astype(v.dtype)
        return jnp.einsum('bhgqk,bkhd->bqhgd', pr, v)

    o = lax.map(one_block, qb)
    return o.transpose(1, 0, 2, 3, 4, 5).reshape(b, lq, hkv * g * hd)


def hgrn_chunk_scan(q, k, v, log_f, s0):
    b, l, h, dk = q.shape
    n = l // HGRN_CHUNK

    def to_chunks(t):
        return t.reshape(b, n, HGRN_CHUNK, h, t.shape[-1]).transpose(1, 0, 3, 2, 4)

    lower = jnp.tril(jnp.ones((HGRN_CHUNK, HGRN_CHUNK), dtype=bool))[:, :, None]

    def step(s, inp):
        qc, kc, vc, lfc = inp
        cum = jnp.cumsum(lfc, axis=2)
        inter = jnp.einsum('bhtd,bhde->bhte', qc * jnp.exp(cum), s)
        diff = cum[:, :, :, None, :] - cum[:, :, None, :, :]
        decay = jnp.where(lower, jnp.exp(jnp.where(lower, diff, 0.0)), 0.0)
        scores = jnp.einsum('bhtd,bhtsd,bhsd->bhts', qc, decay, kc)
        intra = jnp.einsum('bhts,bhse->bhte', scores, vc)
        last = cum[:, :, -1, :]
        s_new = jnp.exp(last)[..., None] * s + jnp.einsum(
            'bhsd,bhse->bhde', kc * jnp.exp(last[:, :, None, :] - cum), vc)
        return s_new, inter + intra

    s_fin, out = lax.scan(step, s0, (to_chunks(q), to_chunks(k), to_chunks(v), to_chunks(log_f)))
    out = out.transpose(1, 0, 3, 2, 4).reshape(b, l, h, v.shape[-1])
    return out, s_fin


def hgrn_branch(q, i, z_fwd, z_bwd, lower_bound, s0, norm_g):
    b, l, _ = q.shape
    q32 = q.astype(jnp.float32).reshape(b, l, HGRN_HEADS, HGRN_DK)
    v32 = i.astype(jnp.float32).reshape(b, l, HGRN_HEADS, HGRN_DV)
    outs, finals = [], []
    for d, z in enumerate((z_fwd, z_bwd)):
        z32 = z.astype(jnp.float32).reshape(b, l, HGRN_HEADS, HGRN_DK)
        lb = lower_bound[d].astype(jnp.float32).reshape(HGRN_HEADS, HGRN_DK)
        f = lb + (1.0 - lb) * jax.nn.sigmoid(z32)
        log_f = jnp.log(jnp.maximum(f, F_FLOOR))
        kk = 1.0 - f
        qd, kd, vd, fd = q32, kk, v32, log_f
        if d == 1:
            qd, kd, vd, fd = (jnp.flip(t, axis=1) for t in (qd, kd, vd, fd))
        o, s_fin = hgrn_chunk_scan(qd, kd, vd, fd, s0[:, d].astype(jnp.float32))
        outs.append(o if d == 0 else jnp.flip(o, axis=1))
        finals.append(s_fin)
    o = rmsnorm(outs[0] + outs[1], norm_g)
    return o.reshape(b, l, HGRN_VWIDTH).astype(q.dtype), jnp.stack(finals, axis=1)


def trunk_layer(x, shift, scale, gate, p, ctx):
    b, l, _ = x.shape
    h = rmsnorm(x, p['norm_pre']) * (1.0 + scale) + shift
    proj = h @ p['w_in']
    (u_a, g_a, u_b, g_b, q_c, k_c, v_c, g_c,
     q_d, i_d, zf_d, zb_d, g_d, m) = split_cols(proj)
    if ctx is None:
        s5_h0_re = jnp.zeros((b, 2, S5_GROUPS, S5_STATE), jnp.float32)
        s5_h0_im = jnp.zeros((b, 2, S5_GROUPS, S5_STATE), jnp.float32)
        hgrn_s0 = jnp.zeros((b, 2, HGRN_HEADS, HGRN_DK, HGRN_DV), jnp.float32)
    else:
        ctx_k, ctx_v, s5_h0_re, s5_h0_im, hgrn_s0 = ctx

    y_a = fourier_mix(u_a, p['fourier_w'])
    y_b, s5_re, s5_im = s5_branch(u_b, p, s5_h0_re, s5_h0_im)
    q, k, v = attention_heads(q_c, k_c, v_c, p['q_norm'], p['k_norm'])
    if ctx is None:
        y_c = block_attention(q, k, v)
    else:
        ang = axial_angles(l)
        q = apply_axial_rope(q, ang)
        k_lat = apply_axial_rope(k, ang)
        keys = jnp.concatenate([k_lat, ctx_k.astype(k.dtype)], axis=1)
        vals = jnp.concatenate([v, ctx_v.astype(v.dtype)], axis=1)
        y_c = block_attention(q, keys, vals)
    y_d, hgrn_s = hgrn_branch(q_d, i_d, zf_d, zb_d, p['lower_bound'], hgrn_s0, p['hgrn_norm'])

    merge = jax.nn.sigmoid(m.reshape(b, l, N_BRANCHES, D_MODEL))
    branches = ((y_a, g_a, p['w_proj_a']), (y_b, g_b, p['w_proj_b']),
                (y_c, g_c, p['w_proj_c']), (y_d, g_d, p['w_proj_d']))
    mixed = None
    for j, (y, g, w) in enumerate(branches):
        term = merge[:, :, j] * ((y * jax.nn.silu(g)) @ w)
        mixed = term if mixed is None else mixed + term
    out = mixed @ p['w_out']
    x_new = x + gate * rmsnorm(out, p['norm_post'])
    if ctx is None:
        return x_new, (k, v, s5_re, s5_im, hgrn_s)
    return x_new, None


def setup_inputs(seed: int = 0) -> dict:
    key = jax.random.key(seed)
    ks = iter(jax.random.split(key, 48))
    f32 = jnp.float32

    def nrm(shape, s=1.0):
        return jax.random.normal(next(ks), shape, f32) * s

    def gain(shape):
        return 1.0 + nrm(shape, 0.02)

    inp = {}
    inp['x_prompt'] = nrm((BATCH, SEQ, D_MODEL))
    inp['x_sample'] = nrm((DEC_BATCH, DEC_SEQ, D_MODEL))
    inp['c'] = nrm((DEC_BATCH, D_MODEL))
    inp['cache_k'] = nrm((DEC_BATCH, DEPTH, PAST_LEN, N_KV_HEADS, HEAD_DIM))
    inp['cache_v'] = nrm((DEC_BATCH, DEPTH, PAST_LEN, N_KV_HEADS, HEAD_DIM))
    inp['state_s5_re'] = nrm((DEC_BATCH, DEPTH, 2, S5_GROUPS, S5_STATE), 0.1)
    inp['state_s5_im'] = nrm((DEC_BATCH, DEPTH, 2, S5_GROUPS, S5_STATE), 0.1)
    inp['state_hgrn'] = nrm((DEC_BATCH, DEPTH, 2, HGRN_HEADS, HGRN_DK, HGRN_DV), 0.1)
    inp['c_ctx'] = nrm((D_MODEL,))
    inp['norm_pre'] = gain((DEPTH, D_MODEL))
    inp['norm_post'] = gain((DEPTH, D_MODEL))
    inp['w_mod'] = nrm((DEPTH, D_MODEL, 3 * D_MODEL), 0.3 * D_MODEL ** -0.5)
    inp['b_mod'] = nrm((DEPTH, 3 * D_MODEL), 0.02)
    inp['w_in'] = nrm((DEPTH, D_MODEL, IN_COLS), D_MODEL ** -0.5)
    inp['fourier_w'] = nrm((DEPTH, FOURIER_GROUPS, FOURIER_GROUP_DIM, FOURIER_GROUP_DIM), FOURIER_GROUP_DIM ** -0.5)
    inp['s5_lambda_re'] = -0.5 + nrm((DEPTH, 2, S5_GROUPS, S5_STATE), 0.01)
    inp['s5_lambda_im'] = math.pi * jnp.arange(S5_STATE, dtype=f32) + nrm((DEPTH, 2, S5_GROUPS, S5_STATE), 0.01)
    inp['s5_log_step'] = jax.random.uniform(next(ks), (DEPTH, 2, S5_GROUPS), f32, math.log(1e-3), math.log(1e-1))
    inp['s5_b_re'] = nrm((DEPTH, 2, S5_GROUPS, S5_STATE, S5_GROUP_DIM), (2 * S5_GROUP_DIM) ** -0.5)
    inp['s5_b_im'] = nrm((DEPTH, 2, S5_GROUPS, S5_STATE, S5_GROUP_DIM), (2 * S5_GROUP_DIM) ** -0.5)
    inp['s5_c_re'] = nrm((DEPTH, 2, S5_GROUPS, S5_GROUP_DIM, S5_STATE), (2 * S5_STATE) ** -0.5)
    inp['s5_c_im'] = nrm((DEPTH, 2, S5_GROUPS, S5_GROUP_DIM, S5_STATE), (2 * S5_STATE) ** -0.5)
    inp['s5_d'] = nrm((DEPTH, S5_WIDTH))
    inp['s5_glu_w'] = nrm((DEPTH, S5_WIDTH, S5_WIDTH), S5_WIDTH ** -0.5)
    inp['s5_glu_b'] = nrm((DEPTH, S5_WIDTH), 0.02)
    inp['q_norm'] = gain((DEPTH, HEAD_DIM))
    inp['k_norm'] = gain((DEPTH, HEAD_DIM))
    inp['hgrn_lb_logits'] = nrm((DEPTH, 2, HGRN_WIDTH))
    inp['hgrn_norm'] = gain((DEPTH, HGRN_DV))
    inp['w_proj_a'] = nrm((DEPTH, FOURIER_WIDTH, D_MODEL), FOURIER_WIDTH ** -0.5)
    inp['w_proj_b'] = nrm((DEPTH, S5_WIDTH, D_MODEL), S5_WIDTH ** -0.5)
    inp['w_proj_c'] = nrm((DEPTH, ATTN_WIDTH, D_MODEL), ATTN_WIDTH ** -0.5)
    inp['w_proj_d'] = nrm((DEPTH, HGRN_VWIDTH, D_MODEL), HGRN_VWIDTH ** -0.5)
    inp['w_out'] = nrm((DEPTH, D_MODEL, D_MODEL), D_MODEL ** -0.5)
    return inp


def reference(x_prompt, x_sample, c, cache_k, cache_v, state_s5_re, state_s5_im, state_hgrn, c_ctx,
              norm_pre, norm_post, w_mod, b_mod, w_in, fourier_w,
              s5_lambda_re, s5_lambda_im, s5_log_step, s5_b_re, s5_b_im, s5_c_re, s5_c_im,
              s5_d, s5_glu_w, s5_glu_b, q_norm, k_norm, hgrn_lb_logits, hgrn_norm,
              w_proj_a, w_proj_b, w_proj_c, w_proj_d, w_out):
    lb_w = jax.nn.softmax(hgrn_lb_logits.astype(jnp.float32), axis=0)
    lower_bounds = jnp.cumsum(lb_w, axis=0) - lb_w[0]

    y_p, y_s = x_prompt, x_sample
    ks, vs, s5r, s5i, hg = [], [], [], [], []
    for l in range(DEPTH):
        p = {'norm_pre': norm_pre[l], 'norm_post': norm_post[l], 'w_in': w_in[l],
             'fourier_w': fourier_w[l],
             's5_lambda_re': s5_lambda_re[l], 's5_lambda_im': s5_lambda_im[l],
             's5_log_step': s5_log_step[l], 's5_b_re': s5_b_re[l], 's5_b_im': s5_b_im[l],
             's5_c_re': s5_c_re[l], 's5_c_im': s5_c_im[l], 's5_d': s5_d[l],
             's5_glu_w': s5_glu_w[l], 's5_glu_b': s5_glu_b[l],
             'q_norm': q_norm[l], 'k_norm': k_norm[l],
             'lower_bound': lower_bounds[l], 'hgrn_norm': hgrn_norm[l],
             'w_proj_a': w_proj_a[l], 'w_proj_b': w_proj_b[l], 'w_proj_c': w_proj_c[l],
             'w_proj_d': w_proj_d[l], 'w_out': w_out[l]}
        mod_ctx = jax.nn.silu(c_ctx) @ w_mod[l] + b_mod[l]
        sh, sc, gt = jnp.split(mod_ctx, 3)
        y_p, (k_l, v_l, sr_l, si_l, hg_l) = trunk_layer(y_p, sh, sc, gt, p, None)
        ks.append(k_l)
        vs.append(v_l)
        s5r.append(sr_l)
        s5i.append(si_l)
        hg.append(hg_l)
        mod = jax.nn.silu(c) @ w_mod[l] + b_mod[l]
        sh, sc, gt = (t[:, None, :] for t in jnp.split(mod, 3, axis=-1))
        ctx = (cache_k[:, l], cache_v[:, l], state_s5_re[:, l], state_s5_im[:, l], state_hgrn[:, l])
        y_s, _ = trunk_layer(y_s, sh, sc, gt, p, ctx)

    new_cache_k = jnp.stack(ks, axis=1)
    new_cache_v = jnp.stack(vs, axis=1)
    new_state_s5_re = jnp.stack(s5r, axis=1)
    new_state_s5_im = jnp.stack(s5i, axis=1)
    new_state_hgrn = jnp.stack(hg, axis=1)
    return (y_p, y_s, new_cache_k, new_cache_v, new_state_s5_re, new_state_s5_im, new_state_hgrn)
```

```cpp
#include <hip/hip_runtime.h>
#include <hip/hip_cooperative_groups.h>
#include <cstdio>
namespace cg = cooperative_groups;

typedef unsigned short u16;
using bf16x8 = __attribute__((ext_vector_type(8))) short;
using f32x4 = __attribute__((ext_vector_type(4))) float;
using u32x4 = __attribute__((ext_vector_type(4))) unsigned;

struct Params { const float* in[34]; float* out; char* ws; };

constexpr int DM = 2048;
constexpr int PS = 15360;
constexpr int C_UA = 0, C_GA = 512, C_UB = 1024, C_GB = 1536, C_QC = 2048, C_KC = 3072, C_VC = 3328, C_GC = 3584,
              C_QD = 4608, C_ID = 5120, C_ZF = 5632, C_ZB = 6144, C_GD = 6656, C_M = 7168;
constexpr int ZS = 2560;
constexpr int Z_A = 0, Z_B = 512, Z_C = 1024, Z_D = 2048;
constexpr int RR = 12288;
constexpr int NKMAX = 4608;

constexpr size_t OY_S = 8388608, OCK = 75497472, OCV = 77594624, OS5R = 79691776, OS5I = 79822848, OHG = 79953920;

constexpr size_t OFF_WINT = 0;
constexpr size_t OFF_WPA = OFF_WINT + (size_t)2 * 15360 * 2048 * 2;
constexpr size_t OFF_WPB = OFF_WPA + (size_t)2 * 2048 * 512 * 2;
constexpr size_t OFF_WPC = OFF_WPB + (size_t)2 * 2048 * 512 * 2;
constexpr size_t OFF_WPD = OFF_WPC + (size_t)2 * 2048 * 1024 * 2;
constexpr size_t OFF_WOUT = OFF_WPD + (size_t)2 * 2048 * 512 * 2;
constexpr size_t OFF_GLU = OFF_WOUT + (size_t)2 * 2048 * 2048 * 2;
constexpr size_t OFF_FWT = OFF_GLU + (size_t)2 * 512 * 512 * 2;
constexpr size_t OFF_DFTL = OFF_FWT + (size_t)2 * 4 * 256 * 128 * 2;
constexpr size_t OFF_DFTS = OFF_DFTL + (size_t)4096 * 8192 * 2;
constexpr size_t OFF_MODP = OFF_DFTS + (size_t)256 * 512 * 2;
constexpr size_t OFF_MOD = OFF_MODP + (size_t)16 * 2 * 9 * 6144 * 4;
constexpr size_t OFF_CTR = OFF_MOD + (size_t)2 * 9 * 6144 * 4;
constexpr size_t OFF_H = OFF_CTR + 4096;
constexpr size_t OFF_PROJ = OFF_H + (size_t)RR * 2048 * 2;
constexpr size_t OFF_Z = OFF_PROJ + (size_t)RR * PS * 2;
constexpr size_t OFF_PQT = OFF_Z + (size_t)RR * ZS * 2;
constexpr size_t OFF_YS = OFF_PQT + (size_t)RR * 1024 * 2;
constexpr size_t OFF_YB = OFF_YS + (size_t)2 * RR * 512 * 4;
constexpr size_t OFF_QB = OFF_YB + (size_t)RR * 512 * 2;
constexpr size_t OFF_KB = OFF_QB + (size_t)RR * 1024 * 2;
constexpr size_t OFF_VT = OFF_KB + (size_t)3 * NKMAX * 256 * 2;
constexpr size_t OFF_OHG = OFF_VT + (size_t)3 * 256 * NKMAX * 2;
constexpr size_t OFF_S5LOC = OFF_OHG + (size_t)2 * RR * 512 * 4;
constexpr size_t OFF_MIXED = OFF_S5LOC + (size_t)3072 * 128 * 4;
constexpr size_t OFF_QIB = OFF_MIXED + (size_t)RR * 2048 * 2;
constexpr size_t OFF_DS = OFF_QIB + (size_t)2 * RR * 512 * 2;
constexpr size_t OFF_DEC = OFF_DS + (size_t)2 * 192 * 4 * 128 * 128 * 2;
constexpr size_t OFF_XBAR = OFF_DEC + (size_t)2 * 192 * 4 * 128 * 4;
constexpr size_t OFF_END = OFF_XBAR + 16384;
constexpr size_t OFF_OUTB = OFF_PROJ;

__device__ __forceinline__ float bf2f(u16 h) { return __uint_as_float(((unsigned)h) << 16); }
__device__ __forceinline__ float bflo(unsigned w) { return __uint_as_float(w << 16); }
__device__ __forceinline__ float bfhi(unsigned w) { return __uint_as_float(w & 0xffff0000u); }
typedef float f32x2_t __attribute__((ext_vector_type(2)));
typedef __bf16 bf16x2_t __attribute__((ext_vector_type(2)));
__device__ __forceinline__ unsigned pack2(float a, float b) {
  f32x2_t v = {a, b};
  bf16x2_t r = __builtin_convertvector(v, bf16x2_t);
  return __builtin_bit_cast(unsigned, r);
}
__device__ __forceinline__ u16 f2bf(float f) { return (u16)(pack2(f, f) & 0xffffu); }
__device__ __forceinline__ float sigm(float x) { return __builtin_amdgcn_rcpf(1.f + __expf(-x)); }
__device__ __forceinline__ float silu(float x) { return x * __builtin_amdgcn_rcpf(1.f + __expf(-x)); }
__device__ __forceinline__ float gelu_t(float x) {
  float u = 0.7978845608028654f * (x + 0.044715f * x * x * x);
  float t = 1.f - 2.f * __builtin_amdgcn_rcpf(1.f + __expf(2.f * u));
  return 0.5f * x * (1.f + t);
}
__device__ __forceinline__ float wave_sum(float v) {
#pragma unroll
  for (int o = 32; o > 0; o >>= 1) v += __shfl_xor(v, o);
  return v;
}
__device__ __forceinline__ int grab(int* ctr, int* slot) {
  __syncthreads();
  if (threadIdx.x == 0) *slot = atomicAdd(ctr, 1);
  __syncthreads();
  return *slot;
}

__device__ __forceinline__ int otid() { int t = threadIdx.x; asm volatile("" : "+v"(t)); return t; }
#define XB_TMO      128
#define XB_XCNT(j)  (256  + 64 * (j))
#define XB_XSUB(j)  (1280 + 64 * (j))
#define XB_XGEN(j)  (2304 + 64 * (j))
#define XB_TOP      3328
#define XB_TOPGEN   3392
#define XCD_BAR_WORDS 3456
#define XB_SPIN_CAP (1u << 18)
#define LAS __attribute__((address_space(3)))

__device__ __forceinline__ unsigned xb_ld(unsigned* p)              { return __hip_atomic_load(p, __ATOMIC_RELAXED, __HIP_MEMORY_SCOPE_AGENT); }
__device__ __forceinline__ unsigned xb_add(unsigned* p, unsigned v) { return __hip_atomic_fetch_add(p, v, __ATOMIC_RELAXED, __HIP_MEMORY_SCOPE_AGENT); }
__device__ __forceinline__ unsigned xb_xcc_id() { return (unsigned)__builtin_amdgcn_s_getreg((3 << 11) | 20) & 0xFu; }
#define XB_SPIN(cond, bar) do { unsigned _sp = 0; while (cond) { __builtin_amdgcn_s_sleep(1); \
    if ((++_sp & 255u) == 0u) { if (xb_ld(&(bar)[XB_TMO])) break; if (_sp > XB_SPIN_CAP) { atomicAdd(&(bar)[XB_TMO], 1u); break; } } } } while (0)

struct XcdBarrier {
    unsigned* bar; unsigned x;
    volatile LAS unsigned* st;
};

__device__ __forceinline__ XcdBarrier xcd_barrier_post(unsigned* bar, volatile LAS unsigned* st) {
    XcdBarrier b; b.bar = bar; b.x = xb_xcc_id(); b.st = st;
    if (threadIdx.x == 0) (void)xb_add(&bar[XB_XCNT(b.x)], 1u);
    return b;
}
__device__ __forceinline__ void xcd_barrier_complete(unsigned* bar, unsigned x, unsigned& nloc, unsigned& nx) {
    const unsigned G = gridDim.x * gridDim.y * gridDim.z;
    unsigned sum, cnt, mine, sp = 0u;
    for (;;) {
        sum = 0u; cnt = 0u; mine = 0u;
#pragma unroll
        for (unsigned j = 0; j < 16; ++j) { const unsigned c = xb_ld(&bar[XB_XCNT(j)]); sum += c; cnt += (c > 0u) ? 1u : 0u; mine = (j == x) ? c : mine; }
        if (sum == G) break;
        __builtin_amdgcn_s_sleep(1);
        if ((++sp & 255u) == 0u) { if (xb_ld(&bar[XB_TMO])) break; if (sp > XB_SPIN_CAP) { atomicAdd(&bar[XB_TMO], 1u); break; } }
    }
    nloc = mine > 0u ? mine : 1u; nx = cnt > 0u ? cnt : 1u;
}

__device__ __forceinline__ void xcd_barrier(const XcdBarrier& b) {
    asm volatile("s_waitcnt vmcnt(0)" ::: "memory");
    __syncthreads();
    if (threadIdx.x == 0) {
        unsigned* bar = b.bar;
        __builtin_amdgcn_s_waitcnt(0);
        unsigned nloc = b.st[0], nx = b.st[1];
        if (nloc == 0u) { xcd_barrier_complete(bar, b.x, nloc, nx); b.st[0] = nloc; b.st[1] = nx; }
        const unsigned old = xb_add(&bar[XB_XSUB(b.x)], 1u);
        const unsigned gen = old / nloc;
        if (old + 1u == (gen + 1u) * nloc) {
            __builtin_amdgcn_fence(__ATOMIC_RELEASE, "agent");
            asm volatile("s_waitcnt vmcnt(0)" ::: "memory");
            const unsigned og = xb_add(&bar[XB_TOP], 1u);
            const unsigned tg = og / nx;
            if (og + 1u == (tg + 1u) * nx) xb_add(&bar[XB_TOPGEN], 1u);
            else XB_SPIN(xb_ld(&bar[XB_TOPGEN]) == tg, bar);
            __builtin_amdgcn_fence(__ATOMIC_ACQUIRE, "agent");
            xb_add(&bar[XB_XGEN(b.x)], 1u);
            asm volatile("s_waitcnt vmcnt(0)" ::: "memory");
        } else {
            XB_SPIN(xb_ld(&bar[XB_XGEN(b.x)]) == gen, bar);
            __builtin_amdgcn_fence(__ATOMIC_ACQUIRE, "agent");
            asm volatile("s_waitcnt vmcnt(0)" ::: "memory");
        }
    }
    __syncthreads();
}

__device__ __forceinline__ void gbar(unsigned* cnt, unsigned& target) {
  asm volatile("s_waitcnt vmcnt(0)" ::: "memory");
  __syncthreads();
  target += gridDim.x;
  if (threadIdx.x == 0) {
    __builtin_amdgcn_fence(__ATOMIC_RELEASE, "agent");
    asm volatile("s_waitcnt vmcnt(0)" ::: "memory");
    __hip_atomic_fetch_add(cnt, 1u, __ATOMIC_RELAXED, __HIP_MEMORY_SCOPE_AGENT);
    while (__hip_atomic_load(cnt, __ATOMIC_RELAXED, __HIP_MEMORY_SCOPE_AGENT) < target) __builtin_amdgcn_s_sleep(1);
    __builtin_amdgcn_fence(__ATOMIC_ACQUIRE, "agent");
    asm volatile("s_waitcnt vmcnt(0)" ::: "memory");
  }
  __syncthreads();
}
__device__ __forceinline__ const float* x_in_row(const Params& p, int layer, int unit, int t) {
  size_t off = (unit == 0) ? (size_t)t * DM : (size_t)((unit - 1) * 4096 + t) * DM;
  if (layer == 0) return ((unit == 0) ? p.in[0] : p.in[1]) + off;
  return p.out + ((unit == 0) ? 0 : OY_S) + off;
}
__device__ __forceinline__ float* y_out_row(const Params& p, int unit, int t) {
  size_t off = (unit == 0) ? (size_t)t * DM : (size_t)((unit - 1) * 4096 + t) * DM;
  return p.out + ((unit == 0) ? 0 : OY_S) + off;
}

constexpr int LDT = 40;
__device__ __forceinline__ void gemm_tile(const u16* __restrict__ A, size_t lda, const u16* __restrict__ B, size_t ldb,
                                          int K, f32x4 (&acc)[4][4], u16* sm) {
  const int tid = otid() & 255, lane = tid & 63, wid = tid >> 6, wr = wid >> 1, wc = wid & 1, fr = lane & 15, fq = lane >> 4;
  u16* As = sm;
  u16* Bs = sm + 2 * 128 * LDT;
  const int lrow = tid >> 2, lkc = (tid & 3) * 8;
  const u16* Ag = A + (size_t)lrow * lda + lkc;
  const u16* Bg = B + (size_t)lrow * ldb + lkc;
  const size_t a64 = 64 * lda, b64 = 64 * ldb;
  uint4 ra0 = *(const uint4*)(Ag), ra1 = *(const uint4*)(Ag + a64);
  uint4 rb0 = *(const uint4*)(Bg), rb1 = *(const uint4*)(Bg + b64);
  __syncthreads();
  *(uint4*)(As + lrow * LDT + lkc) = ra0;
  *(uint4*)(As + (lrow + 64) * LDT + lkc) = ra1;
  *(uint4*)(Bs + lrow * LDT + lkc) = rb0;
  *(uint4*)(Bs + (lrow + 64) * LDT + lkc) = rb1;
  __syncthreads();
  const int nk = K >> 5;
  for (int kt = 0; kt < nk; ++kt) {
    const int cur = kt & 1;
    const bool more = (kt + 1 < nk);
    if (more) {
      const int ko = (kt + 1) * 32;
      ra0 = *(const uint4*)(Ag + ko); ra1 = *(const uint4*)(Ag + a64 + ko);
      rb0 = *(const uint4*)(Bg + ko); rb1 = *(const uint4*)(Bg + b64 + ko);
    }
    const u16* as = As + cur * 128 * LDT;
    const u16* bs = Bs + cur * 128 * LDT;
    bf16x8 af[4], bfg[4];
#pragma unroll
    for (int i = 0; i < 4; ++i) {
      af[i] = *(const bf16x8*)(as + (wr * 64 + i * 16 + fr) * LDT + fq * 8);
      bfg[i] = *(const bf16x8*)(bs + (wc * 64 + i * 16 + fr) * LDT + fq * 8);
    }
#pragma unroll
    for (int ni = 0; ni < 4; ++ni)
#pragma unroll
      for (int mi = 0; mi < 4; ++mi)
        acc[ni][mi] = __builtin_amdgcn_mfma_f32_16x16x32_bf16(bfg[ni], af[mi], acc[ni][mi], 0, 0, 0);
    if (more) {
      u16* aw = As + (cur ^ 1) * 128 * LDT;
      u16* bw = Bs + (cur ^ 1) * 128 * LDT;
      *(uint4*)(aw + lrow * LDT + lkc) = ra0;
      *(uint4*)(aw + (lrow + 64) * LDT + lkc) = ra1;
      *(uint4*)(bw + lrow * LDT + lkc) = rb0;
      *(uint4*)(bw + (lrow + 64) * LDT + lkc) = rb1;
    }
    __syncthreads();
  }
}
#define ACC_ZERO(acc) _Pragma("unroll") for (int _a = 0; _a < 4; ++_a) _Pragma("unroll") for (int _b = 0; _b < 4; ++_b) acc[_a][_b] = f32x4{0.f, 0.f, 0.f, 0.f}
#define EPI_IDX const int tid_ = otid() & 255, lane_ = tid_ & 63, wid_ = tid_ >> 6, wr_ = wid_ >> 1, wc_ = wid_ & 1, fr_ = lane_ & 15, fq_ = lane_ >> 4
#define EPI_ROW(mi) (wr_ * 64 + (mi) * 16 + fr_)
#define EPI_COL(ni) (wc_ * 64 + (ni) * 16 + fq_ * 4)


__device__ __forceinline__ int lds_byte2(int r, int c) {
  int st = (r >> 4) * 2 + (c >> 5), ob = (r & 15) * 64 + (c & 31) * 2;
  return st * 1024 + (ob ^ (((ob >> 9) & 1) << 5));
}
__device__ __forceinline__ void stage_rc2(int b, int& R, int& C) {
  int st = b >> 10, sb = b & 1023, swz = sb ^ (((sb >> 9) & 1) << 5);
  R = (st >> 1) * 16 + swz / 64;
  C = (st & 1) * 32 + (swz % 64) / 2;
}
using i32x4 = __attribute__((ext_vector_type(4))) int;
template <int BN>
__device__ __forceinline__ void gemm256(const u16* __restrict__ A, int lda, const u16* __restrict__ B, int ldb, int K,
                                        f32x4 (&acc)[(BN == 256) ? 8 : 4][4], char* shm) {
  constexpr int MT = (BN == 256) ? 8 : 4, WM = MT * 16;
  constexpr int TA = 256 * 64 * 2, TB = BN * 64 * 2, STAGE = TA + TB;
  constexpr int GLA = 4, GLB = TB / 8192;
  const int tid = otid(), wid = tid >> 6, lane = tid & 63, fr = lane & 15, fq = lane >> 4;
  const int wr = (BN == 256) ? (wid >> 2) : (wid >> 1), wc = (BN == 256) ? (wid & 3) : (wid & 1);
  int oa[GLA], ob[GLB];
#pragma unroll
  for (int i = 0; i < GLA; ++i) { int R, C; stage_rc2(wid * 1024 + i * 8192 + lane * 16, R, C); oa[i] = R * lda + C; }
#pragma unroll
  for (int i = 0; i < GLB; ++i) { int R, C; stage_rc2(wid * 1024 + i * 8192 + lane * 16, R, C); ob[i] = R * ldb + C; }
  i32x4 sa[GLA], sb[GLB];
  char* wbase = shm + wid * 1024 + lane * 16;
#define G_ISSUE(kt) do { _Pragma("unroll") for (int i = 0; i < GLA; ++i) sa[i] = *(const i32x4*)(A + oa[i] + (kt) * 64); \
                         _Pragma("unroll") for (int i = 0; i < GLB; ++i) sb[i] = *(const i32x4*)(B + ob[i] + (kt) * 64); } while (0)
#define G_WRITE(buf) do { _Pragma("unroll") for (int i = 0; i < GLA; ++i) *(i32x4*)(wbase + (buf) * STAGE + i * 8192) = sa[i]; \
                          _Pragma("unroll") for (int i = 0; i < GLB; ++i) *(i32x4*)(wbase + (buf) * STAGE + TA + i * 8192) = sb[i]; } while (0)
  const int nt = K >> 6;
  G_ISSUE(0);
  __syncthreads();
  G_WRITE(0);
  G_ISSUE(1);
  __syncthreads();
  for (int t = 0; t < nt; ++t) {
    const int cur = t & 1;
    if (t + 1 < nt) G_WRITE(cur ^ 1);
    if (t + 2 < nt) G_ISSUE(t + 2);
    const char* sA = shm + cur * STAGE;
    const char* sB = sA + TA;
#pragma unroll
    for (int ks = 0; ks < 2; ++ks) {
      bf16x8 At[MT], Bf[4];
#pragma unroll
      for (int m = 0; m < MT; ++m) At[m] = *(const bf16x8*)(sA + lds_byte2(wr * WM + m * 16 + fr, ks * 32 + fq * 8));
#pragma unroll
      for (int n = 0; n < 4; ++n) Bf[n] = *(const bf16x8*)(sB + lds_byte2(wc * 64 + n * 16 + fr, ks * 32 + fq * 8));
#pragma unroll
      for (int m = 0; m < MT; ++m)
#pragma unroll
        for (int n = 0; n < 4; ++n) acc[m][n] = __builtin_amdgcn_mfma_f32_16x16x32_bf16(Bf[n], At[m], acc[m][n], 0, 0, 0);
    }
    __syncthreads();
  }
#undef G_ISSUE
#undef G_WRITE
}

template <int BN, class SegFn, class EndFn>
__device__ __forceinline__ void gemm256_stream(int nseg, SegFn seg, EndFn endf, f32x4 (&acc)[(BN == 256) ? 8 : 4][4], char* shm) {
  constexpr int MT = (BN == 256) ? 8 : 4, WM = MT * 16;
  constexpr int TA = 256 * 64 * 2, TB = BN * 64 * 2, STAGE = 65536;
  constexpr int GLA = 4, GLB = TB / 8192;
  const int tid = otid(), wid = tid >> 6, lane = tid & 63, fr = lane & 15, fq = lane >> 4;
  const int wr = (BN == 256) ? (wid >> 2) : (wid >> 1), wc = (BN == 256) ? (wid & 3) : (wid & 1);
  int total = 0;
  for (int s_ = 0; s_ < nseg; ++s_) { const u16 *a_, *b_; int la_, lb_, nk_; seg(s_, a_, la_, b_, lb_, nk_); total += nk_; }
  int ps = 0, pk = 0, pnk, plda, pldb;
  const u16 *pA, *pB;
  seg(0, pA, plda, pB, pldb, pnk);
  unsigned oa[GLA], ob[GLB];
#define S_OFFS() do { _Pragma("unroll") for (int i = 0; i < GLA; ++i) { int R_, C_; stage_rc2(wid * 1024 + i * 8192 + lane * 16, R_, C_); \
      oa[i] = (unsigned)(R_ * plda + C_) * 2u; if (i < GLB) ob[i] = (unsigned)(R_ * pldb + C_) * 2u; } } while (0)
  S_OFFS();
  int cs = 0, ck = 0, cnk = pnk;
  char* wbase = shm + (wid & 7) * 1024;
#define S_STAGE(buf) do { \
    const char* ak_ = (const char*)pA + pk * 128; \
    const char* bk_ = (const char*)pB + pk * 128; \
    _Pragma("unroll") for (int i = 0; i < GLA; ++i) \
      __builtin_amdgcn_global_load_lds((const unsigned*)(ak_ + oa[i]), (unsigned*)(wbase + (buf) * STAGE + i * 8192), 16, 0, 0); \
    _Pragma("unroll") for (int i = 0; i < GLB; ++i) \
      __builtin_amdgcn_global_load_lds((const unsigned*)(bk_ + ob[i]), (unsigned*)(wbase + (buf) * STAGE + TA + i * 8192), 16, 0, 0); \
    if (++pk == pnk) { pk = 0; if (++ps < nseg) { seg(ps, pA, plda, pB, pldb, pnk); S_OFFS(); } } } while (0)
  __syncthreads();
  S_STAGE(0);
  asm volatile("s_waitcnt vmcnt(0)" ::: "memory");
  __syncthreads();
#define S_BODY(cur) do { \
    if (g + 1 < total) S_STAGE((cur) ^ 1); \
    const char* sA = shm + (cur) * STAGE; \
    const char* sB = sA + TA; \
    _Pragma("unroll") for (int ks = 0; ks < 2; ++ks) { \
      bf16x8 At[MT], Bf[4]; \
      _Pragma("unroll") for (int m = 0; m < MT; ++m) At[m] = *(const bf16x8*)(sA + (lds_byte2(wr * WM + m * 16 + fr, ks * 32 + fq * 8) & 0x7FFF)); \
      _Pragma("unroll") for (int n = 0; n < 4; ++n) Bf[n] = *(const bf16x8*)(sB + (lds_byte2(wc * 64 + n * 16 + fr, ks * 32 + fq * 8) & 0x7FFF)); \
      _Pragma("unroll") for (int m = 0; m < MT; ++m) \
        _Pragma("unroll") for (int n = 0; n < 4; ++n) acc[m][n] = __builtin_amdgcn_mfma_f32_16x16x32_bf16(Bf[n], At[m], acc[m][n], 0, 0, 0); \
      __builtin_amdgcn_sched_group_barrier(0x100, 6, 0); \
      _Pragma("unroll") for (int m = 0; m < MT; ++m) { \
        __builtin_amdgcn_sched_group_barrier(0x008, 4, 0); \
        if (m + 2 < MT) __builtin_amdgcn_sched_group_barrier(0x100, 1, 0); \
      } \
    } \
    if (++ck == cnk) { \
      endf(cs, acc); \
      _Pragma("unroll") for (int m = 0; m < MT; ++m) \
        _Pragma("unroll") for (int n = 0; n < 4; ++n) acc[m][n] = f32x4{0.f, 0.f, 0.f, 0.f}; \
      ck = 0; \
      if (++cs < nseg) { const u16 *a_, *b_; int la_, lb_; seg(cs, a_, la_, b_, lb_, cnk); } \
    } \
    asm volatile("s_waitcnt vmcnt(0)" ::: "memory"); \
    __syncthreads(); \
    ++g; } while (0)
  for (int g = 0; g < total;) {
    S_BODY(0);
    if (g < total) S_BODY(1);
  }
#undef S_BODY
#undef S_STAGE
#undef S_OFFS
}

#define EPI256(BN_) const int tid_ = otid(), wid_ = tid_ >> 6, lane_ = tid_ & 63, fr_ = lane_ & 15, fq_ = lane_ >> 4, \
    wr_ = ((BN_) == 256) ? (wid_ >> 2) : (wid_ >> 1), wc_ = ((BN_) == 256) ? (wid_ & 3) : (wid_ & 1), wm_ = ((BN_) == 256) ? 128 : 64
#define E256_ROW(m) (wr_ * wm_ + (m) * 16 + fr_)
#define E256_COL(n) (wc_ * 64 + (n) * 16 + fq_ * 4)

__device__ __forceinline__ void conv_transpose(const float* __restrict__ src, int K, int N, u16* __restrict__ dst, float* tile) {
  const int tid = otid(), lane = tid & 63, w = tid >> 6;
  const int ntn = N >> 8, nt = (K >> 6) * ntn;
  for (int t = blockIdx.x; t < nt; t += gridDim.x) {
    const int k0 = (t / ntn) << 6, n0 = (t % ntn) << 8;
    const float* sp = src + (size_t)(k0 + w * 8) * N + n0 + lane * 4;
    const float4 v0 = *(const float4*)(sp), v1 = *(const float4*)(sp + (size_t)N), v2 = *(const float4*)(sp + (size_t)2 * N), v3 = *(const float4*)(sp + (size_t)3 * N);
    const float4 v4 = *(const float4*)(sp + (size_t)4 * N), v5 = *(const float4*)(sp + (size_t)5 * N), v6 = *(const float4*)(sp + (size_t)6 * N), v7 = *(const float4*)(sp + (size_t)7 * N);
    __syncthreads();
    float* tw = tile + (w * 8) * 260 + lane * 4;
    *(float4*)(tw) = v0; *(float4*)(tw + 260) = v1; *(float4*)(tw + 520) = v2; *(float4*)(tw + 780) = v3;
    *(float4*)(tw + 1040) = v4; *(float4*)(tw + 1300) = v5; *(float4*)(tw + 1560) = v6; *(float4*)(tw + 1820) = v7;
    __syncthreads();
    const int kg = tid & 7;
#pragma unroll
    for (int i = 0; i < 4; ++i) {
      const int n = (tid >> 3) + i * 64;
      const float* tp = tile + (kg * 8) * 260 + n;
      uint4 o;
      o.x = pack2(tp[0], tp[260]); o.y = pack2(tp[2 * 260], tp[3 * 260]);
      o.z = pack2(tp[4 * 260], tp[5 * 260]); o.w = pack2(tp[6 * 260], tp[7 * 260]);
      *(uint4*)(dst + (size_t)(n0 + n) * K + k0 + kg * 8) = o;
    }
  }
}

__device__ __forceinline__ void s5_item(const Params& p, int layer, int rd, int bi, int pass, u16* smem) {
  const int tid = otid(), lane = tid & 63, wid = tid >> 6, fr = lane & 15, fq = lane >> 4;
  const int w = bi * 8 + wid;
  const int lu = w >> 10, rem = w & 1023, d = rem & 1, g = (rem >> 1) & 31, ss = rem >> 6;
  const int unit = rd * 3 + lu;
  const bool ctx = (unit == 0);
  const int L = ctx ? 256 : 4096;
  const int seq = ctx ? ss : 0, seg = ctx ? 0 : ss;
  const int rowbase = lu * 4096 + seq * L;
  const u16* proj = (const u16*)(p.ws + OFF_PROJ);
  float* bul = (float*)smem + wid * 2560;
  u16* Hs = smem + 40960 + wid * (16 * 136);
  const int pg = ((layer * 2 + d) * 32 + g);
  const float step = __expf(p.in[17][pg]);
  float lbr, lbi;
  {
    const float lre = p.in[15][pg * 64 + lane], lim = p.in[16][pg * 64 + lane];
    const float mag = __expf(lre * step);
    lbr = mag * __cosf(lim * step); lbi = mag * __sinf(lim * step);
  }
  bf16x8 bbf[8], bbl[8];
#pragma unroll
  for (int q = 0; q < 4; ++q) {
    const int n = q * 16 + fr;
    const float lre = p.in[15][pg * 64 + n], lim = p.in[16][pg * 64 + n];
    const float mag = __expf(lre * step);
    const float br_ = mag * __cosf(lim * step), bi_ = mag * __sinf(lim * step);
    const float nr = br_ - 1.f, den = lre * lre + lim * lim;
    const float fre = (nr * lre + bi_ * lim) / den, fim = (bi_ * lre - nr * lim) / den;
    const float* br = p.in[18] + ((size_t)pg * 64 + n) * 16 + (fq & 1) * 8;
    const float* bim = p.in[19] + ((size_t)pg * 64 + n) * 16 + (fq & 1) * 8;
    const float msk = (fq < 2) ? 1.f : 0.f;
    u32x4 ure, uim, lre_, lim_;
#pragma unroll
    for (int i = 0; i < 4; ++i) {
      const float a0 = br[2 * i] * msk, b0 = bim[2 * i] * msk, a1 = br[2 * i + 1] * msk, b1 = bim[2 * i + 1] * msk;
      const float r0 = fre * a0 - fim * b0, r1 = fre * a1 - fim * b1, m0 = fre * b0 + fim * a0, m1 = fre * b1 + fim * a1;
      ure[i] = pack2(r0, r1);
      uim[i] = pack2(m0, m1);
      lre_[i] = pack2(r0 - bflo(ure[i]), r1 - bfhi(ure[i]));
      lim_[i] = pack2(m0 - bflo(uim[i]), m1 - bfhi(uim[i]));
    }
    bbf[q] = __builtin_bit_cast(bf16x8, ure);
    bbf[4 + q] = __builtin_bit_cast(bf16x8, uim);
    bbl[q] = __builtin_bit_cast(bf16x8, lre_);
    bbl[4 + q] = __builtin_bit_cast(bf16x8, lim_);
  }
  float hr = 0.f, hi = 0.f;
  bf16x8 cf[4];
  u16* ysd = (u16*)(p.ws + OFF_YS) + (size_t)d * RR * 512;
  float* loc = (float*)(p.ws + OFF_S5LOC);
  if (pass == 2) {
    if (!ctx) {
      const size_t si = ((((size_t)(unit - 1) * 2 + layer) * 2 + d) * 32 + g) * 64 + lane;
      hr = p.in[5][si]; hi = p.in[6][si];
    }
    float ar = lbr, ai = lbi;
#pragma unroll
    for (int i = 0; i < 8; ++i) { float t = ar * ar - ai * ai; ai = 2.f * ar * ai; ar = t; }
    for (int i = 0; i < seg; ++i) {
      const int wi = (lu << 10) + (i << 6) + (g << 1) + d;
      const float lr_ = loc[(size_t)wi * 128 + lane], li_ = loc[(size_t)wi * 128 + 64 + lane];
      const float t = ar * hr - ai * hi + lr_;
      hi = ar * hi + ai * hr + li_;
      hr = t;
    }
    const float* cre = p.in[20] + ((size_t)pg * 16 + fr) * 64;
    const float* cim = p.in[21] + ((size_t)pg * 16 + fr) * 64;
#pragma unroll
    for (int ks = 0; ks < 4; ++ks) {
      const float* src = (ks < 2) ? (cre + ks * 32 + fq * 8) : (cim + (ks - 2) * 32 + fq * 8);
      const float sg = (ks < 2) ? 1.f : -1.f;
      u32x4 uc;
#pragma unroll
      for (int i = 0; i < 4; ++i) uc[i] = pack2(sg * src[2 * i], sg * src[2 * i + 1]);
      cf[ks] = __builtin_bit_cast(bf16x8, uc);
    }
  }
  auto load_u = [&](int sbg) -> u32x4 {
    const int pos = seg * 256 + sbg * 16 + fr;
    const int l = d ? (L - 1 - pos) : pos;
    u32x4 v = *(const u32x4*)(proj + (size_t)(rowbase + l) * PS + C_UB + g * 16 + (fq & 1) * 8);
    if (fq >= 2) v = u32x4{0u, 0u, 0u, 0u};
    return v;
  };
  u32x4 unext = load_u(0);
  for (int sbg = 0; sbg < 16; ++sbg) {
    const bf16x8 uf = __builtin_bit_cast(bf16x8, unext);
    if (sbg + 1 < 16) unext = load_u(sbg + 1);
#pragma unroll
    for (int nt = 0; nt < 8; ++nt) {
      f32x4 a = f32x4{0.f, 0.f, 0.f, 0.f};
      a = __builtin_amdgcn_mfma_f32_16x16x32_bf16(uf, bbl[nt], a, 0, 0, 0);
      a = __builtin_amdgcn_mfma_f32_16x16x32_bf16(uf, bbf[nt], a, 0, 0, 0);
      *(f32x4*)(bul + (nt * 16 + fr) * 20 + fq * 4) = a;
    }
    asm volatile("s_waitcnt lgkmcnt(0)" ::: "memory"); __builtin_amdgcn_wave_barrier();
    float bre[16], bim_[16];
#pragma unroll
    for (int k = 0; k < 4; ++k) {
      const f32x4 x = *(const f32x4*)(bul + lane * 20 + k * 4), y = *(const f32x4*)(bul + (64 + lane) * 20 + k * 4);
      bre[4 * k] = x[0]; bre[4 * k + 1] = x[1]; bre[4 * k + 2] = x[2]; bre[4 * k + 3] = x[3];
      bim_[4 * k] = y[0]; bim_[4 * k + 1] = y[1]; bim_[4 * k + 2] = y[2]; bim_[4 * k + 3] = y[3];
    }
    asm volatile("s_waitcnt lgkmcnt(0)" ::: "memory"); __builtin_amdgcn_wave_barrier();
#pragma unroll
    for (int s2 = 0; s2 < 16; ++s2) {
      const float t = lbr * hr - lbi * hi + bre[s2];
      hi = lbr * hi + lbi * hr + bim_[s2];
      hr = t;
      if (pass == 2) { Hs[s2 * 136 + lane] = f2bf(hr); Hs[s2 * 136 + 64 + lane] = f2bf(hi); }
    }
    if (pass == 2) {
      asm volatile("s_waitcnt lgkmcnt(0)" ::: "memory"); __builtin_amdgcn_wave_barrier();
      f32x4 ya = f32x4{0.f, 0.f, 0.f, 0.f};
#pragma unroll
      for (int ks = 0; ks < 4; ++ks) {
        const bf16x8 hf = *(const bf16x8*)(Hs + fr * 136 + ks * 32 + fq * 8);
        ya = __builtin_amdgcn_mfma_f32_16x16x32_bf16(hf, cf[ks], ya, 0, 0, 0);
      }
#pragma unroll
      for (int j = 0; j < 4; ++j) {
        const int pos = seg * 256 + sbg * 16 + fq * 4 + j;
        const int l = d ? (L - 1 - pos) : pos;
        ysd[(size_t)(rowbase + l) * 512 + g * 16 + fr] = f2bf(ya[j]);
      }
      asm volatile("s_waitcnt lgkmcnt(0)" ::: "memory"); __builtin_amdgcn_wave_barrier();
    }
  }
  if (pass == 1) {
    loc[(size_t)w * 128 + lane] = hr;
    loc[(size_t)w * 128 + 64 + lane] = hi;
  } else if (ctx) {
    const size_t oi = ((((size_t)seq * 2 + layer) * 2 + d) * 32 + g) * 64 + lane;
    p.out[OS5R + oi] = hr;
    p.out[OS5I + oi] = hi;
  }
}

__device__ __forceinline__ void hgrnA_item(const Params& p, int layer, int gc, int h, char* shm) {
  const int tid = otid(), lane = tid & 63, w = tid >> 6, fr = lane & 15, fq = lane >> 4;
  const int d = tid & 127, tq = tid >> 7;
  const u16* proj = (const u16*)(p.ws + OFF_PROJ);
  u16* Qm = (u16*)shm;
  u16* Km = (u16*)(shm + 17408);
  u16* KlT = (u16*)(shm + 34816);
  u16* VT = (u16*)(shm + 53248);
  u16* Pm = (u16*)(shm + 71680);
  float* tot = (float*)(shm + 80896);
  const int rowb = gc * 64;
  for (int dir = 0; dir < 2; ++dir) {
    float lb = 0.f;
    if (layer == 1) {
      const int ci = dir * 512 + h * 128 + d;
      const float l0 = p.in[27][ci], l1 = p.in[27][1024 + ci];
      lb = 1.f / (1.f + __expf(l0 - l1));
    }
    float cl[16], kk[16], qv[16];
    float c = 0.f;
    const int zc = (dir ? C_ZB : C_ZF) + h * 128 + d;
    u16 rz[16], rq[16], rvv[16];
#pragma unroll
    for (int i = 0; i < 16; ++i) {
      const int t = tq * 16 + i;
      const size_t ro = (size_t)(rowb + (dir ? 63 - t : t)) * PS;
      rz[i] = proj[ro + zc];
      rq[i] = proj[ro + C_QD + h * 128 + d];
      rvv[i] = proj[ro + C_ID + h * 128 + d];
    }
    __builtin_amdgcn_sched_barrier(0);
    __syncthreads();
#pragma unroll
    for (int i = 0; i < 16; ++i) {
      const int t = tq * 16 + i;
      const float z = bf2f(rz[i]);
      const float f = lb + (1.f - lb) * sigm(z);
      kk[i] = 1.f - f;
      c += __logf(fmaxf(f, 1e-30f));
      cl[i] = c;
      qv[i] = bf2f(rq[i]);
      VT[d * 72 + t] = rvv[i];
    }
    tot[tq * 128 + d] = c;
    __syncthreads();
    const float t0 = tot[d], t1 = tot[128 + d], t2 = tot[256 + d], t3 = tot[384 + d];
    const float off = (tq == 0) ? 0.f : (tq == 1) ? t0 : (tq == 2) ? (t0 + t1) : (t0 + t1 + t2);
    const float mref = t0 + t1, last = t0 + t1 + t2 + t3;
    u16* qib = (u16*)(p.ws + OFF_QIB) + (size_t)dir * RR * 512;
#pragma unroll
    for (int i = 0; i < 16; ++i) {
      const int t = tq * 16 + i;
      const int row = rowb + (dir ? 63 - t : t);
      const float cum = off + cl[i];
      qib[(size_t)row * 512 + h * 128 + d] = f2bf(qv[i] * __expf(cum));
      Qm[t * 136 + d] = f2bf(qv[i] * __expf(fminf(cum - mref, 80.f)));
      Km[t * 136 + d] = f2bf(kk[i] * __expf(fminf(mref - cum, 80.f)));
      KlT[d * 72 + t] = f2bf(kk[i] * __expf(last - cum));
    }
    if (tq == 0) ((float*)(p.ws + OFF_DEC))[((size_t)(dir * 192 + gc) * 4 + h) * 128 + d] = __expf(last);
    __syncthreads();
    {
      const int mt = w >> 1;
#pragma unroll
      for (int nn = 0; nn < 2; ++nn) {
        const int nt = (w & 1) * 2 + nn;
        f32x4 a = f32x4{0.f, 0.f, 0.f, 0.f};
#pragma unroll
        for (int ks = 0; ks < 4; ++ks) {
          const bf16x8 mf = *(const bf16x8*)(Qm + (mt * 16 + fr) * 136 + ks * 32 + fq * 8);
          const bf16x8 nf = *(const bf16x8*)(Km + (nt * 16 + fr) * 136 + ks * 32 + fq * 8);
          a = __builtin_amdgcn_mfma_f32_16x16x32_bf16(nf, mf, a, 0, 0, 0);
        }
        const int t = mt * 16 + fr, s0 = nt * 16 + fq * 4;
        const float p0 = (s0 + 0 <= t) ? a[0] : 0.f, p1 = (s0 + 1 <= t) ? a[1] : 0.f;
        const float p2 = (s0 + 2 <= t) ? a[2] : 0.f, p3 = (s0 + 3 <= t) ? a[3] : 0.f;
        *(uint2*)(Pm + t * 72 + s0) = uint2{pack2(p0, p1), pack2(p2, p3)};
      }
    }
    __syncthreads();
    {
      const int mt = w & 3, ntb = (w >> 2) * 4;
      u16* og = (u16*)(p.ws + OFF_OHG) + (size_t)dir * RR * 512;
      const int t = mt * 16 + fr;
      const int row = rowb + (dir ? 63 - t : t);
      bf16x8 mf0 = *(const bf16x8*)(Pm + t * 72 + fq * 8), mf1 = *(const bf16x8*)(Pm + t * 72 + 32 + fq * 8);
#pragma unroll
      for (int nn = 0; nn < 4; ++nn) {
        const int nt = ntb + nn;
        f32x4 a = f32x4{0.f, 0.f, 0.f, 0.f};
        const bf16x8 nf0 = *(const bf16x8*)(VT + (nt * 16 + fr) * 72 + fq * 8), nf1 = *(const bf16x8*)(VT + (nt * 16 + fr) * 72 + 32 + fq * 8);
        a = __builtin_amdgcn_mfma_f32_16x16x32_bf16(nf0, mf0, a, 0, 0, 0);
        a = __builtin_amdgcn_mfma_f32_16x16x32_bf16(nf1, mf1, a, 0, 0, 0);
        *(uint2*)(og + (size_t)row * 512 + h * 128 + nt * 16 + fq * 4) = uint2{pack2(a[0], a[1]), pack2(a[2], a[3])};
      }
    }
    {
      const int mt = w;
      u16* ds = (u16*)(p.ws + OFF_DS) + ((size_t)(dir * 192 + gc) * 4 + h) * 16384;
      const bf16x8 mf0 = *(const bf16x8*)(VT + (mt * 16 + fr) * 72 + fq * 8), mf1 = *(const bf16x8*)(VT + (mt * 16 + fr) * 72 + 32 + fq * 8);
#pragma unroll
      for (int nt = 0; nt < 8; ++nt) {
        f32x4 a = f32x4{0.f, 0.f, 0.f, 0.f};
        const bf16x8 nf0 = *(const bf16x8*)(KlT + (nt * 16 + fr) * 72 + fq * 8), nf1 = *(const bf16x8*)(KlT + (nt * 16 + fr) * 72 + 32 + fq * 8);
        a = __builtin_amdgcn_mfma_f32_16x16x32_bf16(nf0, mf0, a, 0, 0, 0);
        a = __builtin_amdgcn_mfma_f32_16x16x32_bf16(nf1, mf1, a, 0, 0, 0);
        *(uint2*)(ds + (size_t)(mt * 16 + fr) * 128 + nt * 16 + fq * 4) = uint2{pack2(a[0], a[1]), pack2(a[2], a[3])};
      }
    }
  }
  __syncthreads();
}

__device__ __forceinline__ void hgrnB2_item(const Params& p, int layer, int gc, int hp) {
  const int tid = otid(), lane = tid & 63, w = tid >> 6, fr = lane & 15, fq = lane >> 4;
  const int mt = w & 3, h = hp * 2 + (w >> 2);
  const size_t row = (size_t)gc * 64 + mt * 16 + fr;
  const u16* qib = (const u16*)(p.ws + OFF_QIB);
  const u16* dsb = (const u16*)(p.ws + OFF_DS);
  f32x4 acc[8];
#pragma unroll
  for (int nt = 0; nt < 8; ++nt) acc[nt] = f32x4{0.f, 0.f, 0.f, 0.f};
#pragma unroll
  for (int dir = 0; dir < 2; ++dir) {
    const u16* qrow = qib + ((size_t)dir * RR + row) * 512 + h * 128 + fq * 8;
    const u16* sT = dsb + ((size_t)(dir * 192 + gc) * 4 + h) * 16384 + (size_t)fr * 128 + fq * 8;
    bf16x8 mf[4];
#pragma unroll
    for (int ks = 0; ks < 4; ++ks) mf[ks] = *(const bf16x8*)(qrow + ks * 32);
    bf16x8 nfa[8], nfb[8];
#pragma unroll
    for (int nt = 0; nt < 8; ++nt) nfa[nt] = *(const bf16x8*)(sT + (size_t)nt * 16 * 128);
#pragma unroll
    for (int nt = 0; nt < 8; ++nt) nfb[nt] = *(const bf16x8*)(sT + (size_t)nt * 16 * 128 + 32);
    __builtin_amdgcn_sched_barrier(0);
#pragma unroll
    for (int nt = 0; nt < 8; ++nt) acc[nt] = __builtin_amdgcn_mfma_f32_16x16x32_bf16(nfa[nt], mf[0], acc[nt], 0, 0, 0);
#pragma unroll
    for (int nt = 0; nt < 8; ++nt) nfa[nt] = *(const bf16x8*)(sT + (size_t)nt * 16 * 128 + 64);
    __builtin_amdgcn_sched_barrier(0);
#pragma unroll
    for (int nt = 0; nt < 8; ++nt) acc[nt] = __builtin_amdgcn_mfma_f32_16x16x32_bf16(nfb[nt], mf[1], acc[nt], 0, 0, 0);
#pragma unroll
    for (int nt = 0; nt < 8; ++nt) nfb[nt] = *(const bf16x8*)(sT + (size_t)nt * 16 * 128 + 96);
    __builtin_amdgcn_sched_barrier(0);
#pragma unroll
    for (int nt = 0; nt < 8; ++nt) acc[nt] = __builtin_amdgcn_mfma_f32_16x16x32_bf16(nfa[nt], mf[2], acc[nt], 0, 0, 0);
#pragma unroll
    for (int nt = 0; nt < 8; ++nt) acc[nt] = __builtin_amdgcn_mfma_f32_16x16x32_bf16(nfb[nt], mf[3], acc[nt], 0, 0, 0);
  }
  const u16* og0 = (const u16*)(p.ws + OFF_OHG) + row * 512 + h * 128 + fq * 4;
  const u16* og1 = og0 + (size_t)RR * 512;
  float ss = 0.f;
  uint2 o0s[8], o1s[8];
#pragma unroll
  for (int nt = 0; nt < 8; ++nt) { o0s[nt] = *(const uint2*)(og0 + nt * 16); o1s[nt] = *(const uint2*)(og1 + nt * 16); }
  __builtin_amdgcn_sched_barrier(0);
#pragma unroll
  for (int nt = 0; nt < 8; ++nt) {
    const f32x4 a0 = f32x4{bflo(o0s[nt].x), bfhi(o0s[nt].x), bflo(o0s[nt].y), bfhi(o0s[nt].y)};
    const f32x4 a1 = f32x4{bflo(o1s[nt].x), bfhi(o1s[nt].x), bflo(o1s[nt].y), bfhi(o1s[nt].y)};
    acc[nt] += a0 + a1;
    ss += acc[nt][0] * acc[nt][0] + acc[nt][1] * acc[nt][1] + acc[nt][2] * acc[nt][2] + acc[nt][3] * acc[nt][3];
  }
  ss += __shfl_xor(ss, 16); ss += __shfl_xor(ss, 32);
  const float inv = rsqrtf(ss * (1.f / 128.f) + 1e-6f);
  const u16* proj = (const u16*)(p.ws + OFF_PROJ);
  u16* Z = (u16*)(p.ws + OFF_Z);
  float4 gns[8]; uint2 ggs[8];
#pragma unroll
  for (int nt = 0; nt < 8; ++nt) {
    const int e = nt * 16 + fq * 4;
    gns[nt] = *(const float4*)(p.in[28] + (size_t)layer * 128 + e);
    ggs[nt] = *(const uint2*)(proj + row * PS + C_GD + h * 128 + e);
  }
  __builtin_amdgcn_sched_barrier(0);
#pragma unroll
  for (int nt = 0; nt < 8; ++nt) {
    const int e = nt * 16 + fq * 4;
    const float4 gn = gns[nt];
    const uint2 gg = ggs[nt];
    const float r0 = acc[nt][0] * inv * gn.x * silu(bflo(gg.x)), r1 = acc[nt][1] * inv * gn.y * silu(bfhi(gg.x));
    const float r2 = acc[nt][2] * inv * gn.z * silu(bflo(gg.y)), r3 = acc[nt][3] * inv * gn.w * silu(bfhi(gg.y));
    *(uint2*)(Z + row * ZS + Z_D + h * 128 + e) = uint2{pack2(r0, r1), pack2(r2, r3)};
  }
}

__device__ __forceinline__ void attn_item(const Params& p, int unit, int lu, int seq, int head, int qb, u16* smem) {
  const int tid = otid(), lane = tid & 63, wid = tid >> 6, fr = lane & 15, fq = lane >> 4;
  const bool ctx = (unit == 0);
  const int L = ctx ? 256 : 4096;
  const int nkeys = ctx ? 256 : NKMAX;
  const int hkv = head >> 2;
  const int qrow0 = lu * 4096 + seq * L + qb * 256 + wid * 32;
  const u16* Qb = (const u16*)(p.ws + OFF_QB);
  const u16* Kg = (const u16*)(p.ws + OFF_KB) + ((size_t)lu * NKMAX + (ctx ? seq * 256 : 0)) * 256 + hkv * 128;
  const u16* Vg = (const u16*)(p.ws + OFF_VT) + (size_t)lu * 256 * NKMAX + (ctx ? (size_t)(seq * 2 + hkv) * 128 * 256 : (size_t)hkv * 128 * NKMAX);
  bf16x8 qf[2][4];
#pragma unroll
  for (int nt = 0; nt < 2; ++nt)
#pragma unroll
    for (int ks = 0; ks < 4; ++ks)
      qf[nt][ks] = *(const bf16x8*)(Qb + (size_t)(qrow0 + nt * 16 + fr) * 1024 + head * 128 + ks * 32 + fq * 8);
  f32x4 OT[8][2];
#pragma unroll
  for (int a = 0; a < 8; ++a) { OT[a][0] = f32x4{0.f, 0.f, 0.f, 0.f}; OT[a][1] = f32x4{0.f, 0.f, 0.f, 0.f}; }
  float mrun[2] = {0.f, 0.f}, lrun[2] = {0.f, 0.f};
  const int ntile = nkeys >> 6;
  uint4 rk0, rk1, rv0, rv1;
  const int kkey = tid >> 4, kdc = (tid & 15) * 8;
  const int vd = tid >> 3, vkc = (tid & 7) * 8;
#define ATT_ISSUE(kt_) do { \
    const u16* kp_ = Kg + (size_t)((kt_) * 64 + kkey) * 256 + kdc; \
    const u16* vp_ = Vg + (size_t)vd * nkeys + (kt_) * 64 + vkc; \
    rk0 = *(const uint4*)(kp_); rk1 = *(const uint4*)(kp_ + 32 * 256); \
    rv0 = *(const uint4*)(vp_); rv1 = *(const uint4*)(vp_ + (size_t)64 * nkeys); \
  } while (0)
#define ATT_WRITE(buf_) do { u16* ks_ = smem + (buf_) * 17920; u16* vs_ = ks_ + 64 * 136; \
    *(uint4*)(ks_ + (kkey) * 136 + kdc) = rk0; *(uint4*)(ks_ + (kkey + 32) * 136 + kdc) = rk1; \
    *(uint4*)(vs_ + (vd) * 72 + vkc) = rv0; *(uint4*)(vs_ + (vd + 64) * 72 + vkc) = rv1; } while (0)
  ATT_ISSUE(0);
  __syncthreads();
  ATT_WRITE(0);
  if (ntile > 1) ATT_ISSUE(1);
  __syncthreads();
  for (int kt = 0; kt < ntile; ++kt) {
    const u16* Ks = smem + (kt & 1) * 17920;
    const u16* Vs = Ks + 64 * 136;
    f32x4 ST[4][2];
#pragma unroll
    for (int a = 0; a < 4; ++a) {
      ST[a][0] = f32x4{-mrun[0], -mrun[0], -mrun[0], -mrun[0]};
      ST[a][1] = f32x4{-mrun[1], -mrun[1], -mrun[1], -mrun[1]};
    }
#pragma unroll
    for (int ks = 0; ks < 4; ++ks) {
#pragma unroll
      for (int mt = 0; mt < 4; ++mt) {
        const bf16x8 kf = *(const bf16x8*)(Ks + (mt * 16 + fr) * 136 + ks * 32 + fq * 8);
        ST[mt][0] = __builtin_amdgcn_mfma_f32_16x16x32_bf16(kf, qf[0][ks], ST[mt][0], 0, 0, 0);
        ST[mt][1] = __builtin_amdgcn_mfma_f32_16x16x32_bf16(kf, qf[1][ks], ST[mt][1], 0, 0, 0);
      }
    }
    u32x4 pfu[2][2];
#pragma unroll
    for (int nt = 0; nt < 2; ++nt) {
      float mx = fmaxf(fmaxf(ST[0][nt][0], ST[0][nt][1]), fmaxf(ST[0][nt][2], ST[0][nt][3]));
#pragma unroll
      for (int mt = 1; mt < 4; ++mt) mx = fmaxf(mx, fmaxf(fmaxf(ST[mt][nt][0], ST[mt][nt][1]), fmaxf(ST[mt][nt][2], ST[mt][nt][3])));
      mx = fmaxf(mx, __shfl_xor(mx, 16));
      mx = fmaxf(mx, __shfl_xor(mx, 32));
      const bool need = (kt == 0) || (mx > 8.f);
      if (__any(need)) {
        const float delta = need ? mx : 0.f;
        const float alpha = __builtin_amdgcn_exp2f(-delta);
        mrun[nt] += delta;
        lrun[nt] *= alpha;
#pragma unroll
        for (int mt = 0; mt < 4; ++mt) ST[mt][nt] -= delta;
#pragma unroll
        for (int dt = 0; dt < 8; ++dt) OT[dt][nt] *= alpha;
      }
      float ps = 0.f;
#pragma unroll
      for (int mt = 0; mt < 4; ++mt) {
        const float p0 = __builtin_amdgcn_exp2f(ST[mt][nt][0]), p1 = __builtin_amdgcn_exp2f(ST[mt][nt][1]);
        const float p2 = __builtin_amdgcn_exp2f(ST[mt][nt][2]), p3 = __builtin_amdgcn_exp2f(ST[mt][nt][3]);
        ps += (p0 + p1) + (p2 + p3);
        pfu[nt][mt >> 1][(mt & 1) * 2 + 0] = pack2(p0, p1);
        pfu[nt][mt >> 1][(mt & 1) * 2 + 1] = pack2(p2, p3);
      }
      lrun[nt] += ps;
    }
    if (kt + 1 < ntile) ATT_WRITE((kt + 1) & 1);
    if (kt + 2 < ntile) ATT_ISSUE(kt + 2);
#pragma unroll
    for (int kk = 0; kk < 2; ++kk) {
      const bf16x8 pf0 = __builtin_bit_cast(bf16x8, pfu[0][kk]), pf1 = __builtin_bit_cast(bf16x8, pfu[1][kk]);
#pragma unroll
      for (int dt = 0; dt < 8; ++dt) {
        const u16* vrow = Vs + (dt * 16 + fr) * 72 + kk * 32 + fq * 4;
        const uint2 v0 = *(const uint2*)(vrow), v1 = *(const uint2*)(vrow + 16);
        const bf16x8 vf = __builtin_bit_cast(bf16x8, (u32x4){v0.x, v0.y, v1.x, v1.y});
        OT[dt][0] = __builtin_amdgcn_mfma_f32_16x16x32_bf16(vf, pf0, OT[dt][0], 0, 0, 0);
        OT[dt][1] = __builtin_amdgcn_mfma_f32_16x16x32_bf16(vf, pf1, OT[dt][1], 0, 0, 0);
      }
    }
    __syncthreads();
  }
  const u16* proj = (const u16*)(p.ws + OFF_PROJ);
  u16* Z = (u16*)(p.ws + OFF_Z);
#pragma unroll
  for (int nt = 0; nt < 2; ++nt) {
    float lt = lrun[nt];
    lt += __shfl_xor(lt, 16); lt += __shfl_xor(lt, 32);
    const float inv = 1.f / lt;
    const size_t row = (size_t)(qrow0 + nt * 16 + fr);
    uint2 ggs[8];
#pragma unroll
    for (int dt = 0; dt < 8; ++dt) ggs[dt] = *(const uint2*)(proj + row * PS + C_GC + head * 128 + dt * 16 + fq * 4);
    __builtin_amdgcn_sched_barrier(0);
#pragma unroll
    for (int dt = 0; dt < 8; ++dt) {
      const int dd = head * 128 + dt * 16 + fq * 4;
      const uint2 gg = ggs[dt];
      const float o0 = OT[dt][nt][0] * inv * silu(bflo(gg.x)), o1 = OT[dt][nt][1] * inv * silu(bfhi(gg.x));
      const float o2 = OT[dt][nt][2] * inv * silu(bflo(gg.y)), o3 = OT[dt][nt][3] * inv * silu(bfhi(gg.y));
      *(uint2*)(Z + row * ZS + Z_C + dd) = uint2{pack2(o0, o1), pack2(o2, o3)};
    }
  }
  __syncthreads();
}

__global__ void __launch_bounds__(512) mega(Params p) {
  __shared__ __attribute__((aligned(1024))) char shm[131072];
  u16* smem = (u16*)shm;
  __shared__ int s_slot;
  __shared__ uint4 xb_words;
  if (threadIdx.x == 0) xb_words = make_uint4(0u, 0u, 0u, 0u);
  cg::grid_group grid = cg::this_grid();
  const int bid = blockIdx.x, nb = gridDim.x;
#define PHASE_IDS const int tid = otid(), lane = tid & 63, wid = tid >> 6; const size_t gtid = (size_t)bid * 512 + tid; const int gwave = bid * 8 + wid; const int gi = wid >> 2; u16* smg = smem + gi * 20480; (void)gi; (void)smg; (void)lane; (void)gtid; (void)gwave
  const size_t gthreads = (size_t)nb * 512;
  const int nwaves = nb * 8;
  char* ws = p.ws;
#define WinT ((u16*)(p.ws + OFF_WINT))
#define WpA ((u16*)(p.ws + OFF_WPA))
#define WpB ((u16*)(p.ws + OFF_WPB))
#define WpC ((u16*)(p.ws + OFF_WPC))
#define WpD ((u16*)(p.ws + OFF_WPD))
#define WoutT ((u16*)(p.ws + OFF_WOUT))
#define GluT ((u16*)(p.ws + OFF_GLU))
#define FWt ((u16*)(p.ws + OFF_FWT))
#define DftL ((u16*)(p.ws + OFF_DFTL))
#define DftS ((u16*)(p.ws + OFF_DFTS))
#define modp ((float*)(p.ws + OFF_MODP))
#define modb ((float*)(p.ws + OFF_MOD))
#define ctr ((int*)(p.ws + OFF_CTR))
#define hbuf ((u16*)(p.ws + OFF_H))
#define proj ((u16*)(p.ws + OFF_PROJ))
#define Z ((u16*)(p.ws + OFF_Z))
#define PQt ((u16*)(p.ws + OFF_PQT))
#define ys ((u16*)(p.ws + OFF_YS))
#define yb ((u16*)(p.ws + OFF_YB))
#define Qb ((u16*)(p.ws + OFF_QB))
#define Kb ((u16*)(p.ws + OFF_KB))
#define Vt ((u16*)(p.ws + OFF_VT))
#define mixed ((u16*)(p.ws + OFF_MIXED))
#define outb ((u16*)(p.ws + OFF_OUTB))

  {
  PHASE_IDS;
  if (bid == 0) for (int i = tid; i < 1024; i += 512) ctr[i] = 0;
  if (bid == 0) for (int i = tid; i < 4096; i += 512) ((unsigned*)(p.ws + OFF_XBAR))[i] = 0u;
  for (int l = 0; l < 2; ++l) {
    conv_transpose(p.in[13] + (size_t)l * 2048 * 15360, 2048, 15360, WinT + (size_t)l * 15360 * 2048, (float*)smem);
    conv_transpose(p.in[29] + (size_t)l * 512 * 2048, 512, 2048, WpA + (size_t)l * 2048 * 512, (float*)smem);
    conv_transpose(p.in[30] + (size_t)l * 512 * 2048, 512, 2048, WpB + (size_t)l * 2048 * 512, (float*)smem);
    conv_transpose(p.in[31] + (size_t)l * 1024 * 2048, 1024, 2048, WpC + (size_t)l * 2048 * 1024, (float*)smem);
    conv_transpose(p.in[32] + (size_t)l * 512 * 2048, 512, 2048, WpD + (size_t)l * 2048 * 512, (float*)smem);
    conv_transpose(p.in[33] + (size_t)l * 2048 * 2048, 2048, 2048, WoutT + (size_t)l * 2048 * 2048, (float*)smem);
    conv_transpose(p.in[23] + (size_t)l * 512 * 512, 512, 512, GluT + (size_t)l * 512 * 512, (float*)smem);
  }
  for (size_t idx = gtid; idx < (size_t)2048 * 4096; idx += gthreads) {
    const int k = (int)(idx >> 12), l = (int)(idx & 4095);
    const int m = (k * l) & 4095;
    const float a = (float)m * (6.283185307179586f / 4096.f);
    DftL[(size_t)k * 8192 + l] = f2bf(__cosf(a) * (1.f / 64.f));
    DftL[(size_t)k * 8192 + 4096 + l] = f2bf(-__sinf(a) * (1.f / 64.f));
  }
  for (size_t idx = gtid; idx < (size_t)256 * 256; idx += gthreads) {
    const int k = (int)(idx >> 8), l = (int)(idx & 255);
    const int m = (k * l) & 255;
    const float a = (float)m * (6.283185307179586f / 256.f);
    DftS[(size_t)k * 512 + l] = f2bf(__cosf(a) * (1.f / 16.f));
    DftS[(size_t)k * 512 + 256 + l] = f2bf(-__sinf(a) * (1.f / 16.f));
  }
  for (size_t idx = gtid; idx < (size_t)2 * 4 * 256 * 128; idx += gthreads) {
    const int c = (int)(idx & 127), n = (int)((idx >> 7) & 255), lg = (int)(idx >> 15);
    const float* w = p.in[14] + (size_t)lg * 128 * 128 + (n & 127);
    float acc = 0.f;
    for (int m = 0; m < 128; ++m) {
      const float a = (float)((m * c) & 127) * (6.283185307179586f / 128.f);
      const float tr = (n < 128) ? __cosf(a) : __sinf(a);
      acc += tr * w[(size_t)m * 128];
    }
    FWt[idx] = f2bf(acc * 0.08838834764831845f);
  }
  for (int it = bid; it < 384; it += nb) {
    const int layer = it / 192, rem = it % 192, cb = rem >> 4, kc = rem & 15;
    float* sc = (float*)smem;
    __syncthreads();
    for (int idx = tid; idx < 9 * 128; idx += 512) {
      const int u = idx >> 7, k = idx & 127;
      const float cv = (u == 0) ? p.in[8][kc * 128 + k] : p.in[2][(size_t)(u - 1) * 2048 + kc * 128 + k];
      sc[idx] = silu(cv);
    }
    __syncthreads();
    const int col = cb * 512 + tid;
    float a9[9];
#pragma unroll
    for (int u = 0; u < 9; ++u) a9[u] = 0.f;
    const float* wm = p.in[11] + ((size_t)layer * 2048 + kc * 128) * 6144 + col;
    for (int k0 = 0; k0 < 128; k0 += 16) {
      float wv[16];
#pragma unroll
      for (int j = 0; j < 16; ++j) wv[j] = wm[(size_t)(k0 + j) * 6144];
      __builtin_amdgcn_sched_barrier(0);
#pragma unroll
      for (int j = 0; j < 16; ++j)
#pragma unroll
        for (int u = 0; u < 9; ++u) a9[u] += sc[u * 128 + k0 + j] * wv[j];
    }
#pragma unroll
    for (int u = 0; u < 9; ++u) modp[((size_t)(kc * 2 + layer) * 9 + u) * 6144 + col] = a9[u];
  }
  }
  grid.sync();
  XcdBarrier xb = xcd_barrier_post((unsigned*)(p.ws + OFF_XBAR), (volatile LAS unsigned*)&xb_words);
  {
  PHASE_IDS;
  for (size_t idx = gtid; idx < (size_t)2 * 9 * 6144; idx += gthreads) {
    const int col = (int)(idx % 6144), lu_ = (int)(idx / 6144), layer = lu_ / 9;
    float a = p.in[12][(size_t)layer * 6144 + col];
    for (int kc = 0; kc < 16; ++kc) a += modp[(size_t)kc * 2 * 9 * 6144 + idx];
    modb[idx] = a;
  }
  }
  grid.sync();

  unsigned* gcnt = (unsigned*)(ctr + 1000);
  unsigned gtarget = 0u;
  for (int rd = 0; rd < 3; ++rd) {
    for (int layer = 0; layer < 2; ++layer) {
      if (layer == 0) {
      PHASE_IDS;
      for (int row = gwave; row < RR; row += nwaves) {
        const int lu = row >> 12, t = row & 4095, unit = rd * 3 + lu;
        const float4* x4 = (const float4*)x_in_row(p, layer, unit, t);
        const float* md = modb + (size_t)(layer * 9 + unit) * 6144;
        float4 v[8];
        float ss = 0.f;
#pragma unroll
        for (int i = 0; i < 8; ++i) { v[i] = x4[lane + i * 64]; ss += v[i].x * v[i].x + v[i].y * v[i].y + v[i].z * v[i].z + v[i].w * v[i].w; }
        ss = wave_sum(ss);
        const float inv = rsqrtf(ss * (1.f / 2048.f) + 1e-6f);
#pragma unroll
        for (int i = 0; i < 8; ++i) {
          const int col = (lane + i * 64) * 4;
          const float4 g = *(const float4*)(p.in[9] + (size_t)layer * 2048 + col);
          const float4 sh = *(const float4*)(md + col), sc = *(const float4*)(md + 2048 + col);
          const float h0 = v[i].x * inv * g.x * (1.f + sc.x) + sh.x, h1 = v[i].y * inv * g.y * (1.f + sc.y) + sh.y;
          const float h2 = v[i].z * inv * g.z * (1.f + sc.z) + sh.z, h3 = v[i].w * inv * g.w * (1.f + sc.w) + sh.w;
          *(uint2*)(hbuf + (size_t)row * 2048 + col) = uint2{pack2(h0, h1), pack2(h2, h3)};
        }
      }
      xcd_barrier(xb);
      }
      {
        const u16* W = WinT + (size_t)layer * 15360 * 2048;
        const int nfull = (48 * 60 / nb) * nb;
        const int ntl = nfull / nb;
        f32x4 acc[8][4];
#pragma unroll
        for (int a_ = 0; a_ < 8; ++a_)
#pragma unroll
          for (int b_ = 0; b_ < 4; ++b_) acc[a_][b_] = f32x4{0.f, 0.f, 0.f, 0.f};
        if (ntl > 0)
        gemm256_stream<256>(ntl,
          [&](int s_, const u16*& A_, int& lda_, const u16*& B_, int& ldb_, int& nk_) {
            const int t = bid + s_ * nb, mt = t % 48, nt = t / 48;
            A_ = hbuf + (size_t)mt * 256 * 2048; lda_ = 2048; B_ = W + (size_t)nt * 256 * 2048; ldb_ = 2048; nk_ = 32;
          },
          [&](int s_, f32x4 (&ac)[8][4]) {
            const int t = bid + s_ * nb, mt = t % 48, nt = t / 48;
            EPI256(256);
            const bool mg = (nt * 256 >= C_M);
#pragma unroll
            for (int m = 0; m < 8; ++m)
#pragma unroll
              for (int n = 0; n < 4; ++n) {
                f32x4 a = ac[m][n];
                if (mg) { a[0] = sigm(a[0]); a[1] = sigm(a[1]); a[2] = sigm(a[2]); a[3] = sigm(a[3]); }
                *(uint2*)(proj + (size_t)(mt * 256 + E256_ROW(m)) * PS + nt * 256 + E256_COL(n)) = uint2{pack2(a[0], a[1]), pack2(a[2], a[3])};
              }
          }, acc, shm);
        const int nhalf = (48 * 60 - nfull) * 2;
        if (bid < nhalf) {
          f32x4 acc2[4][4];
          ACC_ZERO(acc2);
          const int t = nfull + (bid >> 1), mt = t % 48, nt = t / 48, hf = bid & 1;
          gemm256_stream<128>(1,
            [&](int s_, const u16*& A_, int& lda_, const u16*& B_, int& ldb_, int& nk_) {
              A_ = hbuf + (size_t)mt * 256 * 2048; lda_ = 2048; B_ = W + ((size_t)nt * 256 + hf * 128) * 2048; ldb_ = 2048; nk_ = 32;
            },
            [&](int s_, f32x4 (&ac)[4][4]) {
              EPI256(128);
              const bool mg = (nt * 256 >= C_M);
#pragma unroll
              for (int m = 0; m < 4; ++m)
#pragma unroll
                for (int n = 0; n < 4; ++n) {
                  f32x4 a = ac[m][n];
                  if (mg) { a[0] = sigm(a[0]); a[1] = sigm(a[1]); a[2] = sigm(a[2]); a[3] = sigm(a[3]); }
                  *(uint2*)(proj + (size_t)(mt * 256 + E256_ROW(m)) * PS + nt * 256 + hf * 128 + E256_COL(n)) = uint2{pack2(a[0], a[1]), pack2(a[2], a[3])};
                }
            }, acc2, shm);
        }
      }
      xcd_barrier(xb);
      {
        PHASE_IDS;
        int* cq3 = ctr + 64 + (rd * 2 + layer);
        while (true) {
        const int it = grab(cq3, &s_slot);
        if (it >= 1752) break;
        {
        int layer_o = layer, rd_o = rd;
        asm volatile("" : "+s"(layer_o), "+s"(rd_o));
        const int layer = layer_o, rd = rd_o;
        if (it >= 1368) {
          const int t2 = it - 1368;
          const int t = t2 * 2 + gi;
          const int mt = t % 96, gn = t / 96, g = gn >> 1, nh = gn & 1;
          f32x4 acc[4][4];
          ACC_ZERO(acc);
          gemm_tile(proj + (size_t)mt * 128 * PS + C_UA + g * 128, PS, FWt + ((size_t)(layer * 4 + g) * 256 + nh * 128) * 128, 128, 128, acc, smg);
          EPI_IDX;
#pragma unroll
          for (int mi = 0; mi < 4; ++mi) {
            const int row = mt * 128 + EPI_ROW(mi);
            const int lu = row >> 12, tt = row & 4095, unit = rd * 3 + lu;
            const bool ctx = (unit == 0);
            const int L = ctx ? 256 : 4096;
            const int seq = ctx ? (tt >> 8) : 0, l = ctx ? (tt & 255) : tt;
            u16* base = PQt + (size_t)lu * 4096 * 1024 + (size_t)seq * 512 * 2 * L + (size_t)nh * L + l;
#pragma unroll
            for (int ni = 0; ni < 4; ++ni) {
              const int dcol = EPI_COL(ni);
#pragma unroll
              for (int j = 0; j < 4; ++j) base[(size_t)(g * 128 + dcol + j) * 2 * L] = f2bf(acc[ni][mi][j]);
            }
          }
        }
        if (it < 384) s5_item(p, layer, rd, it, 1, smem);
        else if (it < 1152) hgrnA_item(p, layer, (it - 384) >> 2, (it - 384) & 3, shm);
        const float qscale = 0.08838834764831845f * 1.4426950408889634f;
        if (it >= 1152 && it < 1344)
        for (int rr = 0; rr < 8; ++rr) {
          const int row = (it - 1152) * 64 + wid * 8 + rr;
          const int lu = row >> 12, t = row & 4095, unit = rd * 3 + lu;
          const bool ctx = (unit == 0);
          const int seq = ctx ? (t >> 8) : 0, l = ctx ? (t & 255) : t;
          const u16* pr = proj + (size_t)row * PS;
          const int a = lane >> 5, i = lane & 31;
          float cs = 1.f, sn = 0.f;
          if (!ctx) {
            const float pos = (float)(a == 0 ? (l >> 6) : (l & 63));
            const float ang = pos * __expf(-(float)i * (9.210340371976184f / 32.f));
            cs = __cosf(ang); sn = __sinf(ang);
          }
          u16 rx1[10], rx2[10], rvx[4];
#pragma unroll
          for (int hh = 0; hh < 10; ++hh) {
            const int cb = (hh < 8) ? (C_QC + hh * 128) : (C_KC + (hh - 8) * 128);
            rx1[hh] = pr[cb + a * 64 + i]; rx2[hh] = pr[cb + a * 64 + 32 + i];
          }
#pragma unroll
          for (int e = 0; e < 4; ++e) rvx[e] = pr[C_VC + lane + e * 64];
          __builtin_amdgcn_sched_barrier(0);
#pragma unroll
          for (int hh = 0; hh < 10; ++hh) {
            const float x1 = bf2f(rx1[hh]), x2 = bf2f(rx2[hh]);
            const float ssq = wave_sum(x1 * x1 + x2 * x2);
            const float inv = rsqrtf(ssq * (1.f / 128.f) + 1e-6f);
            const float* gn = (hh < 8) ? (p.in[25] + layer * 128) : (p.in[26] + layer * 128);
            float y1 = x1 * inv * gn[a * 64 + i], y2 = x2 * inv * gn[a * 64 + 32 + i];
            if (hh >= 8 && ctx) {
              const size_t oi = OCK + ((((size_t)seq * 2 + layer) * 256 + l) * 2 + (hh - 8)) * 128 + a * 64 + i;
              p.out[oi] = y1; p.out[oi + 32] = y2;
            }
            const float r1 = y1 * cs - y2 * sn, r2 = y2 * cs + y1 * sn;
            if (hh < 8) {
              Qb[(size_t)row * 1024 + hh * 128 + a * 64 + i] = f2bf(r1 * qscale);
              Qb[(size_t)row * 1024 + hh * 128 + a * 64 + 32 + i] = f2bf(r2 * qscale);
            } else {
              const size_t kr = (size_t)lu * NKMAX + (ctx ? (seq * 256 + l) : l);
              Kb[kr * 256 + (hh - 8) * 128 + a * 64 + i] = f2bf(r1);
              Kb[kr * 256 + (hh - 8) * 128 + a * 64 + 32 + i] = f2bf(r2);
            }
          }
#pragma unroll
          for (int e = 0; e < 4; ++e) {
            const int idx = lane + e * 64, hkv = idx >> 7, dd = idx & 127;
            const u16 vv = rvx[e];
            if (ctx) {
              p.out[OCV + ((((size_t)seq * 2 + layer) * 256 + l) * 2 + hkv) * 128 + dd] = bf2f(vv);
              Vt[(size_t)lu * 256 * NKMAX + ((size_t)(seq * 2 + hkv) * 128 + dd) * 256 + l] = vv;
            } else {
              Vt[(size_t)lu * 256 * NKMAX + ((size_t)hkv * 128 + dd) * NKMAX + l] = vv;
            }
          }
        }
        if (it >= 1344 && it < 1368) {
          float kv[8][4], vvv[8][4];
#pragma unroll
          for (int rr = 0; rr < 8; ++rr) {
            const int r = (it - 1344) * 64 + wid * 8 + rr;
            const int lu = r >> 9, j = r & 511, unit = rd * 3 + lu;
            const size_t ci = (((size_t)((unit > 0 ? unit : 1) - 1) * 2 + layer) * 512 + j) * 256;
#pragma unroll
            for (int e = 0; e < 4; ++e) { kv[rr][e] = p.in[3][ci + lane + e * 64]; vvv[rr][e] = p.in[4][ci + lane + e * 64]; }
          }
          __builtin_amdgcn_sched_barrier(0);
#pragma unroll
          for (int rr = 0; rr < 8; ++rr) {
            const int r = (it - 1344) * 64 + wid * 8 + rr;
            const int lu = r >> 9, j = r & 511, unit = rd * 3 + lu;
            if (unit != 0) {
#pragma unroll
              for (int e = 0; e < 4; ++e) {
                const int idx = lane + e * 64;
                Kb[((size_t)lu * NKMAX + 4096 + j) * 256 + idx] = f2bf(kv[rr][e]);
                Vt[(size_t)lu * 256 * NKMAX + (size_t)idx * NKMAX + 4096 + j] = f2bf(vvv[rr][e]);
              }
            }
          }
        }
        }
        }
      }
      xcd_barrier(xb);
      {
        const int nl = (rd == 0) ? 2 : 3, ncx = (rd == 0) ? 1 : 0, lu0 = ncx;
        const int n_hl = nl * 32, n_at = nl * 128, n_df = 0, n_hc = nl * 8, n_s5 = 384, n_ac = ncx * 128, n_dc = ncx * 32;
        const int e0 = n_hl, e1 = e0 + n_at, e2 = e1 + n_df, e3 = e2 + n_hc, e4 = e3 + n_s5, e5 = e4 + n_ac, e6 = e5 + n_dc;
        const int nb1 = ncx * 1024 + nl * 64;
        int* cq = ctr + (rd * 2 + layer);
        while (true) {
          int it = grab(cq, &s_slot);
          if (it >= e6 + nb1) break;
          if (it < nb1) {
            const int lu = (ncx && it < 1024) ? 0 : (ncx ? 1 + ((it - 1024) >> 6) : (it >> 6));
            const int ii = (ncx && it < 1024) ? it : (ncx ? ((it - 1024) & 63) : (it & 63));
            const int unit = rd * 3 + lu;
            const bool ctx = (unit == 0);
            const int nch = ctx ? 4 : 64;
            u16* dsb = (u16*)(p.ws + OFF_DS);
            const float* dec = (const float*)(p.ws + OFF_DEC);
            const size_t idx = (size_t)ii * 512 + otid();
            {
              const int dq = (int)(idx & 31), e = (int)((idx >> 5) & 127), h = (int)((idx >> 12) & 3), dir = (int)((idx >> 14) & 1), seq = (int)(idx >> 15);
              const int c0 = lu * 64 + seq * nch;
              float S0 = 0.f, S1 = 0.f, S2 = 0.f, S3 = 0.f;
              if (!ctx) {
                const float* st = p.in[7] + (((((size_t)(unit - 1) * 2 + layer) * 2 + dir) * 4 + h) * 128 + dq * 4) * 128 + e;
                S0 = st[0]; S1 = st[128]; S2 = st[256]; S3 = st[384];
              }
              for (int cc = 0; cc < nch; cc += 4) {
                uint2 tv[4]; float4 dc[4]; u16* ptr[4];
#pragma unroll
                for (int k = 0; k < 4; ++k) {
                  const int gc = dir ? (c0 + nch - 1 - cc - k) : (c0 + cc + k);
                  const size_t bi_ = (size_t)(dir * 192 + gc) * 4 + h;
                  ptr[k] = dsb + (bi_ * 128 + e) * 128 + dq * 4;
                  tv[k] = *(const uint2*)ptr[k];
                  dc[k] = *(const float4*)(dec + bi_ * 128 + dq * 4);
                }
#pragma unroll
                for (int k = 0; k < 4; ++k) {
                  *(uint2*)ptr[k] = uint2{pack2(S0, S1), pack2(S2, S3)};
                  S0 = dc[k].x * S0 + bflo(tv[k].x); S1 = dc[k].y * S1 + bfhi(tv[k].x);
                  S2 = dc[k].z * S2 + bflo(tv[k].y); S3 = dc[k].w * S3 + bfhi(tv[k].y);
                }
              }
              if (ctx) {
                float* o = p.out + OHG + (((((size_t)seq * 2 + layer) * 2 + dir) * 4 + h) * 128 + dq * 4) * 128 + e;
                o[0] = S0; o[128] = S1; o[256] = S2; o[384] = S3;
              }
            }
            continue;
          }
          it -= nb1;
          if (it < e0) {
            const int lu = lu0 + it / 32, r = it % 32, mt = r & 7, nt = r >> 3;
            f32x4 acc[4][4], accA[4][4];
            ACC_ZERO(acc);
            ACC_ZERO(accA);
            const u16* Bm = PQt + (size_t)lu * 4096 * 1024 + (size_t)nt * 128 * 8192;
            gemm256_stream<128>(2,
              [&](int s_, const u16*& A_, int& lda_, const u16*& B_, int& ldb_, int& nk_) {
                A_ = DftL + (size_t)mt * 256 * 8192 + s_ * 4096; lda_ = 8192; B_ = Bm + s_ * 4096; ldb_ = 8192; nk_ = 64;
              },
              [&](int s_, f32x4 (&ac)[4][4]) {
                if (s_ == 0) {
#pragma unroll
                  for (int m = 0; m < 4; ++m)
#pragma unroll
                    for (int n = 0; n < 4; ++n) accA[m][n] = ac[m][n];
                } else {
                  EPI256(128);
                  uint2 gs_[4][4];
#pragma unroll
                  for (int m = 0; m < 4; ++m)
#pragma unroll
                    for (int n = 0; n < 4; ++n)
                      gs_[m][n] = *(const uint2*)(proj + ((size_t)lu * 4096 + mt * 256 + E256_ROW(m)) * PS + C_GA + nt * 128 + E256_COL(n));
                  __builtin_amdgcn_sched_barrier(0);
#pragma unroll
                  for (int m = 0; m < 4; ++m)
#pragma unroll
                    for (int n = 0; n < 4; ++n) {
                      const size_t row = (size_t)lu * 4096 + mt * 256 + E256_ROW(m);
                      const int col = nt * 128 + E256_COL(n);
                      const uint2 gg = gs_[m][n];
                      const f32x4 a = accA[m][n] + ac[m][n];
                      *(uint2*)(Z + row * ZS + Z_A + col) = uint2{pack2(a[0] * silu(bflo(gg.x)), a[1] * silu(bfhi(gg.x))),
                                                                   pack2(a[2] * silu(bflo(gg.y)), a[3] * silu(bfhi(gg.y)))};
                    }
                  __builtin_amdgcn_sched_barrier(0);
#pragma unroll
                  for (int m = 0; m < 4; ++m)
#pragma unroll
                    for (int n = 0; n < 4; ++n)
                      gs_[m][n] = *(const uint2*)(proj + ((size_t)lu * 4096 + ((4096 - (mt * 256 + E256_ROW(m))) & 4095)) * PS + C_GA + nt * 128 + E256_COL(n));
                  __builtin_amdgcn_sched_barrier(0);
#pragma unroll
                  for (int m = 0; m < 4; ++m)
#pragma unroll
                    for (int n = 0; n < 4; ++n) {
                      const int k = mt * 256 + E256_ROW(m);
                      const int col = nt * 128 + E256_COL(n);
                      if (k > 0) {
                        const size_t row = (size_t)lu * 4096 + (4096 - k);
                        const uint2 gg = gs_[m][n];
                        const f32x4 a = accA[m][n] - ac[m][n];
                        *(uint2*)(Z + row * ZS + Z_A + col) = uint2{pack2(a[0] * silu(bflo(gg.x)), a[1] * silu(bfhi(gg.x))),
                                                                     pack2(a[2] * silu(bflo(gg.y)), a[3] * silu(bfhi(gg.y)))};
                      }
                    }
                }
              }, acc, shm);
          } else if (it < e1) {
            const int i2 = it - e0, lu = lu0 + i2 / 128, r = i2 % 128;
            attn_item(p, rd * 3 + lu, lu, 0, r >> 4, r & 15, smem);
          } else if (it < e3) {
            const int i2 = it - e2, lu = lu0 + (i2 >> 3), chg = i2 & 7;
            const int tid_ = otid(), lane_ = tid_ & 63, w_ = tid_ >> 6;
            for (int c = 0; c < 8; ++c) {
              const int ch = chg * 64 + w_ * 8 + c;
              const u16* src = PQt + (size_t)lu * 4096 * 1024 + (size_t)ch * 8192 + lane_ * 8;
              uint4 v[8];
#pragma unroll
              for (int i = 0; i < 8; ++i) v[i] = *(const uint4*)(src + i * 512);
              __builtin_amdgcn_sched_barrier(0);
              float a = 0.f;
#pragma unroll
              for (int i = 0; i < 8; ++i)
                a += (bflo(v[i].x) - bfhi(v[i].x)) + (bflo(v[i].y) - bfhi(v[i].y)) + (bflo(v[i].z) - bfhi(v[i].z)) + (bflo(v[i].w) - bfhi(v[i].w));
              a = wave_sum(a) * (1.f / 64.f);
              if (lane_ == 0) {
                const size_t row = (size_t)lu * 4096 + 2048;
                Z[row * ZS + Z_A + ch] = f2bf(a * silu(bf2f(proj[row * PS + C_GA + ch])));
              }
            }
          } else if (it < e4) {
            s5_item(p, layer, rd, it - e3, 2, smem);
          } else if (it < e5) {
            const int i2 = it - e4, seq = i2 >> 3, r = i2 & 7;
            attn_item(p, 0, 0, seq, r, 0, smem);
          } else {
            const int i2 = it - e5;
            for (int q = 0; q < 2; ++q) {
              const int tix = i2 * 4 + q * 2 + (int)(otid() >> 8), seq = tix >> 3, r = tix & 7, mt = r & 1, nt = r >> 1;
              f32x4 acc[4][4];
              ACC_ZERO(acc);
              gemm_tile(DftS + (size_t)mt * 128 * 512, 512, PQt + (size_t)seq * 512 * 512 + (size_t)nt * 128 * 512, 512, 512, acc, smem + (otid() >> 8) * 20480);
              EPI_IDX;
#pragma unroll
              for (int ni = 0; ni < 4; ++ni)
#pragma unroll
                for (int mi = 0; mi < 4; ++mi) {
                  const size_t row = (size_t)seq * 256 + mt * 128 + EPI_ROW(mi);
                  const int col = nt * 128 + EPI_COL(ni);
                  const uint2 gg = *(const uint2*)(proj + row * PS + C_GA + col);
                  const f32x4 a = acc[ni][mi];
                  *(uint2*)(Z + row * ZS + Z_A + col) = uint2{pack2(a[0] * silu(bflo(gg.x)), a[1] * silu(bfhi(gg.x))),
                                                               pack2(a[2] * silu(bflo(gg.y)), a[3] * silu(bfhi(gg.y)))};
                }
            }
          }
        }
      }
      xcd_barrier(xb);
      {
      PHASE_IDS;
      for (int row = gwave; row < RR; row += nwaves) {
        const u16* pr = proj + (size_t)row * PS;
        {
          const int c0 = lane * 8;
          const uint4 ya_ = *(const uint4*)(ys + (size_t)row * 512 + c0), yb_ = *(const uint4*)(ys + (size_t)(RR + row) * 512 + c0);
          const float4 a0 = float4{bflo(ya_.x), bfhi(ya_.x), bflo(ya_.y), bfhi(ya_.y)}, a1 = float4{bflo(ya_.z), bfhi(ya_.z), bflo(ya_.w), bfhi(ya_.w)};
          const float4 b0 = float4{bflo(yb_.x), bfhi(yb_.x), bflo(yb_.y), bfhi(yb_.y)}, b1 = float4{bflo(yb_.z), bfhi(yb_.z), bflo(yb_.w), bfhi(yb_.w)};
          const float4 d0 = *(const float4*)(p.in[22] + (size_t)layer * 512 + c0), d1 = *(const float4*)(p.in[22] + (size_t)layer * 512 + c0 + 4);
          const uint4 uu = *(const uint4*)(pr + C_UB + c0);
          uint4 o;
          o.x = pack2(gelu_t(a0.x + b0.x + d0.x * bflo(uu.x)), gelu_t(a0.y + b0.y + d0.y * bfhi(uu.x)));
          o.y = pack2(gelu_t(a0.z + b0.z + d0.z * bflo(uu.y)), gelu_t(a0.w + b0.w + d0.w * bfhi(uu.y)));
          o.z = pack2(gelu_t(a1.x + b1.x + d1.x * bflo(uu.z)), gelu_t(a1.y + b1.y + d1.y * bfhi(uu.z)));
          o.w = pack2(gelu_t(a1.z + b1.z + d1.z * bflo(uu.w)), gelu_t(a1.w + b1.w + d1.w * bfhi(uu.w)));
          *(uint4*)(yb + (size_t)row * 512 + c0) = o;
        }
      }
      for (int it = bid; it < 384; it += nb) hgrnB2_item(p, layer, it >> 1, it & 1);
      }
      xcd_barrier(xb);
      for (int t2 = bid; t2 < 96 * 2; t2 += nb) {
        const int gi6 = (int)(otid() >> 8);
        const int t = t2 * 2 + gi6;
        const int mt = t % 96, nt = t / 96;
        f32x4 acc[4][4];
        ACC_ZERO(acc);
        gemm_tile(yb + (size_t)mt * 128 * 512, 512, GluT + (size_t)layer * 512 * 512 + (size_t)nt * 128 * 512, 512, 512, acc, smem + gi6 * 20480);
        EPI_IDX;
        float4 bbs[4]; uint2 yys[4][4], ggs[4][4];
#pragma unroll
        for (int ni = 0; ni < 4; ++ni) {
          bbs[ni] = *(const float4*)(p.in[24] + (size_t)layer * 512 + nt * 128 + EPI_COL(ni));
#pragma unroll
          for (int mi = 0; mi < 4; ++mi) {
            const size_t row = (size_t)mt * 128 + EPI_ROW(mi);
            const int col = nt * 128 + EPI_COL(ni);
            yys[ni][mi] = *(const uint2*)(yb + row * 512 + col);
            ggs[ni][mi] = *(const uint2*)(proj + row * PS + C_GB + col);
          }
        }
        __builtin_amdgcn_sched_barrier(0);
#pragma unroll
        for (int ni = 0; ni < 4; ++ni)
#pragma unroll
          for (int mi = 0; mi < 4; ++mi) {
            const size_t row = (size_t)mt * 128 + EPI_ROW(mi);
            const int col = nt * 128 + EPI_COL(ni);
            const float4 bb = bbs[ni];
            const uint2 yy = yys[ni][mi];
            const uint2 gg = ggs[ni][mi];
            const f32x4 a = acc[ni][mi];
            const float r0 = bflo(yy.x) * sigm(a[0] + bb.x) * silu(bflo(gg.x)), r1 = bfhi(yy.x) * sigm(a[1] + bb.y) * silu(bfhi(gg.x));
            const float r2 = bflo(yy.y) * sigm(a[2] + bb.z) * silu(bflo(gg.y)), r3 = bfhi(yy.y) * sigm(a[3] + bb.w) * silu(bfhi(gg.y));
            *(uint2*)(Z + row * ZS + Z_B + col) = uint2{pack2(r0, r1), pack2(r2, r3)};
          }
      }
      xcd_barrier(xb);
      {
        const int ntl = (48 * 16 - bid + nb - 1) / nb;
        f32x4 mix[4][4], acc[4][4];
        ACC_ZERO(mix);
        ACC_ZERO(acc);
        if (ntl > 0)
        gemm256_stream<128>(ntl * 4,
          [&](int s_, const u16*& A_, int& lda_, const u16*& B_, int& ldb_, int& nk_) {
            const int t = bid + (s_ >> 2) * nb, mt = t % 48, nt = t / 48, j = s_ & 3;
            const int Kj = (j == 2) ? 1024 : 512;
            const int zo = (j == 0) ? Z_A : (j == 1) ? Z_B : (j == 2) ? Z_C : Z_D;
            const u16* Wj = (j == 0) ? WpA : (j == 1) ? WpB : (j == 2) ? WpC : WpD;
            A_ = Z + (size_t)mt * 256 * ZS + zo; lda_ = ZS; B_ = Wj + (size_t)layer * 2048 * Kj + (size_t)nt * 128 * Kj; ldb_ = Kj; nk_ = Kj >> 6;
          },
          [&](int s_, f32x4 (&ac)[4][4]) {
            const int t = bid + (s_ >> 2) * nb, mt = t % 48, nt = t / 48, j = s_ & 3;
            EPI256(128);
            uint2 ggs[4][4];
#pragma unroll
            for (int m = 0; m < 4; ++m)
#pragma unroll
              for (int n = 0; n < 4; ++n)
                ggs[m][n] = *(const uint2*)(proj + ((size_t)mt * 256 + E256_ROW(m)) * PS + C_M + j * 2048 + nt * 128 + E256_COL(n));
            __builtin_amdgcn_sched_barrier(0);
#pragma unroll
            for (int m = 0; m < 4; ++m)
#pragma unroll
              for (int n = 0; n < 4; ++n) {
                const size_t row = (size_t)mt * 256 + E256_ROW(m);
                const int col = nt * 128 + E256_COL(n);
                const uint2 gg = ggs[m][n];
                mix[m][n][0] += bflo(gg.x) * ac[m][n][0];
                mix[m][n][1] += bfhi(gg.x) * ac[m][n][1];
                mix[m][n][2] += bflo(gg.y) * ac[m][n][2];
                mix[m][n][3] += bfhi(gg.y) * ac[m][n][3];
                if (j == 3) {
                  *(uint2*)(mixed + row * 2048 + col) = uint2{pack2(mix[m][n][0], mix[m][n][1]), pack2(mix[m][n][2], mix[m][n][3])};
                  mix[m][n] = f32x4{0.f, 0.f, 0.f, 0.f};
                }
              }
          }, acc, shm);
      }
      xcd_barrier(xb);
      {
        const int ntl = (48 * 16 - bid + nb - 1) / nb;
        f32x4 acc[4][4];
        ACC_ZERO(acc);
        if (ntl > 0)
        gemm256_stream<128>(ntl,
          [&](int s_, const u16*& A_, int& lda_, const u16*& B_, int& ldb_, int& nk_) {
            const int t = bid + s_ * nb, mt = t % 48, nt = t / 48;
            A_ = mixed + (size_t)mt * 256 * 2048; lda_ = 2048; B_ = WoutT + (size_t)layer * 2048 * 2048 + (size_t)nt * 128 * 2048; ldb_ = 2048; nk_ = 32;
          },
          [&](int s_, f32x4 (&ac)[4][4]) {
            const int t = bid + s_ * nb, mt = t % 48, nt = t / 48;
            EPI256(128);
#pragma unroll
            for (int m = 0; m < 4; ++m)
#pragma unroll
              for (int n = 0; n < 4; ++n) {
                const size_t row = (size_t)mt * 256 + E256_ROW(m);
                const int col = nt * 128 + E256_COL(n);
                *(uint2*)(outb + row * 2048 + col) = uint2{pack2(ac[m][n][0], ac[m][n][1]), pack2(ac[m][n][2], ac[m][n][3])};
              }
          }, acc, shm);
      }
      xcd_barrier(xb);
      {
      PHASE_IDS;
      for (int row = gwave; row < RR; row += nwaves) {
        const int lu = row >> 12, t = row & 4095, unit = rd * 3 + lu;
        const float4* x4 = (const float4*)x_in_row(p, layer, unit, t);
        float4* y4 = (float4*)y_out_row(p, unit, t);
        const float* md = modb + (size_t)(layer * 9 + unit) * 6144 + 4096;
        const uint2* o4 = (const uint2*)(outb + (size_t)row * 2048);
        float4 v[8];
        float ss = 0.f;
#pragma unroll
        for (int i = 0; i < 8; ++i) {
          const uint2 ov = o4[lane + i * 64];
          v[i] = float4{bflo(ov.x), bfhi(ov.x), bflo(ov.y), bfhi(ov.y)};
          ss += v[i].x * v[i].x + v[i].y * v[i].y + v[i].z * v[i].z + v[i].w * v[i].w;
        }
        ss = wave_sum(ss);
        const float inv = rsqrtf(ss * (1.f / 2048.f) + 1e-6f);
        float4 xvs[8];
#pragma unroll
        for (int i = 0; i < 8; ++i) xvs[i] = x4[lane + i * 64];
        __builtin_amdgcn_sched_barrier(0);
#pragma unroll
        for (int i = 0; i < 8; ++i) {
          const int col = (lane + i * 64) * 4;
          const float4 g = *(const float4*)(p.in[10] + (size_t)layer * 2048 + col);
          const float4 gt = *(const float4*)(md + col);
          const float4 xv = xvs[i];
          float4 y;
          y.x = xv.x + gt.x * (v[i].x * inv * g.x); y.y = xv.y + gt.y * (v[i].y * inv * g.y);
          y.z = xv.z + gt.z * (v[i].z * inv * g.z); y.w = xv.w + gt.w * (v[i].w * inv * g.w);
          y4[lane + i * 64] = y;
          v[i] = y;
        }
        if (layer == 0) {
          float s2 = 0.f;
#pragma unroll
          for (int i = 0; i < 8; ++i) s2 += v[i].x * v[i].x + v[i].y * v[i].y + v[i].z * v[i].z + v[i].w * v[i].w;
          s2 = wave_sum(s2);
          const float inv2 = rsqrtf(s2 * (1.f / 2048.f) + 1e-6f);
          const float* md1 = modb + (size_t)(9 + unit) * 6144;
#pragma unroll
          for (int i = 0; i < 8; ++i) {
            const int col = (lane + i * 64) * 4;
            const float4 g = *(const float4*)(p.in[9] + 2048 + col);
            const float4 sh = *(const float4*)(md1 + col), sc = *(const float4*)(md1 + 2048 + col);
            const float h0 = v[i].x * inv2 * g.x * (1.f + sc.x) + sh.x, h1 = v[i].y * inv2 * g.y * (1.f + sc.y) + sh.y;
            const float h2 = v[i].z * inv2 * g.z * (1.f + sc.z) + sh.z, h3 = v[i].w * inv2 * g.w * (1.f + sc.w) + sh.w;
            *(uint2*)(hbuf + (size_t)row * 2048 + col) = uint2{pack2(h0, h1), pack2(h2, h3)};
          }
        }
      }
      }
      xcd_barrier(xb);
    }
  }
}

extern "C" void kernel_launch(void* const* d_in, const int* in_sizes, int n_in,
                              void* d_out, int out_size, void* d_ws, size_t ws_size,
                              hipStream_t stream) {
  static int grid_blocks = 0;
  if (!grid_blocks) {
    int dev = 0, cus = 0, per_cu = 0;
    (void)hipGetDevice(&dev);
    (void)hipDeviceGetAttribute(&cus, hipDeviceAttributeMultiprocessorCount, dev);
    (void)hipOccupancyMaxActiveBlocksPerMultiprocessor(&per_cu, mega, 512, 0);
    if (per_cu > 1) per_cu = 1;
    if (per_cu < 1) per_cu = 1;
    grid_blocks = cus * per_cu;
  }
  if (ws_size < OFF_END) { fprintf(stderr, "workspace too small: %zu < %zu\n", ws_size, (size_t)OFF_END); return; }
  Params p{};
  for (int i = 0; i < 34; ++i) p.in[i] = (const float*)d_in[i];
  p.out = (float*)d_out;
  p.ws = (char*)d_ws;
  void* args[] = {&p};
  hipError_t e = hipLaunchCooperativeKernel((void*)mega, dim3(grid_blocks), dim3(512), args, 0, stream);
  if (e != hipSuccess) fprintf(stderr, "cooperative launch failed: %s (grid %d)\n", hipGetErrorString(e), grid_blocks);
}
```

```cpp
#include <hip/hip_runtime.h>
#include <hip/hip_cooperative_groups.h>
#include <cstdio>
namespace cg = cooperative_groups;

typedef unsigned short u16;
using bf16x8 = __attribute__((ext_vector_type(8))) short;
using f32x4 = __attribute__((ext_vector_type(4))) float;
using u32x4 = __attribute__((ext_vector_type(4))) unsigned;

struct Params { const float* in[34]; float* out; char* ws; };

constexpr int DM = 2048;
constexpr int PS = 15360;
constexpr int C_UA = 0, C_GA = 512, C_UB = 1024, C_GB = 1536, C_QC = 2048, C_KC = 3072, C_VC = 3328, C_GC = 3584,
              C_QD = 4608, C_ID = 5120, C_ZF = 5632, C_ZB = 6144, C_GD = 6656, C_M = 7168;
constexpr int ZS = 2560;
constexpr int Z_A = 0, Z_B = 512, Z_C = 1024, Z_D = 2048;
constexpr int RR = 12288;
constexpr int NKMAX = 4608;

constexpr size_t OY_S = 8388608, OCK = 75497472, OCV = 77594624, OS5R = 79691776, OS5I = 79822848, OHG = 79953920;

constexpr size_t OFF_WINT = 0;
constexpr size_t OFF_WPA = OFF_WINT + (size_t)2 * 15360 * 2048 * 2;
constexpr size_t OFF_WPB = OFF_WPA + (size_t)2 * 2048 * 512 * 2;
constexpr size_t OFF_WPC = OFF_WPB + (size_t)2 * 2048 * 512 * 2;
constexpr size_t OFF_WPD = OFF_WPC + (size_t)2 * 2048 * 1024 * 2;
constexpr size_t OFF_WOUT = OFF_WPD + (size_t)2 * 2048 * 512 * 2;
constexpr size_t OFF_GLU = OFF_WOUT + (size_t)2 * 2048 * 2048 * 2;
constexpr size_t OFF_FWT = OFF_GLU + (size_t)2 * 512 * 512 * 2;
constexpr size_t OFF_DFTL = OFF_FWT + (size_t)2 * 4 * 256 * 128 * 2;
constexpr size_t OFF_DFTS = OFF_DFTL + (size_t)4096 * 8192 * 2;
constexpr size_t OFF_MODP = OFF_DFTS + (size_t)256 * 512 * 2;
constexpr size_t OFF_MOD = OFF_MODP + (size_t)16 * 2 * 9 * 6144 * 4;
constexpr size_t OFF_CTR = OFF_MOD + (size_t)2 * 9 * 6144 * 4;
constexpr size_t OFF_H = OFF_CTR + 4096;
constexpr size_t OFF_PROJ = OFF_H + (size_t)RR * 2048 * 2;
constexpr size_t OFF_Z = OFF_PROJ + (size_t)RR * PS * 2;
constexpr size_t OFF_PQT = OFF_Z + (size_t)RR * ZS * 2;
constexpr size_t OFF_YS = OFF_PQT + (size_t)RR * 1024 * 2;
constexpr size_t OFF_YB = OFF_YS + (size_t)2 * RR * 512 * 4;
constexpr size_t OFF_QB = OFF_YB + (size_t)RR * 512 * 2;
constexpr size_t OFF_KB = OFF_QB + (size_t)RR * 1024 * 2;
constexpr size_t OFF_VT = OFF_KB + (size_t)3 * NKMAX * 256 * 2;
constexpr size_t OFF_OHG = OFF_VT + (size_t)3 * 256 * NKMAX * 2;
constexpr size_t OFF_S5LOC = OFF_OHG + (size_t)2 * RR * 512 * 4;
constexpr size_t OFF_MIXED = OFF_S5LOC + (size_t)3072 * 128 * 4;
constexpr size_t OFF_QIB = OFF_MIXED + (size_t)RR * 2048 * 2;
constexpr size_t OFF_DS = OFF_QIB + (size_t)2 * RR * 512 * 2;
constexpr size_t OFF_DEC = OFF_DS + (size_t)2 * 192 * 4 * 128 * 128 * 2;
constexpr size_t OFF_XBAR = OFF_DEC + (size_t)2 * 192 * 4 * 128 * 4;
constexpr size_t OFF_END = OFF_XBAR + 16384;
constexpr size_t OFF_OUTB = OFF_PROJ;

__device__ __forceinline__ float bf2f(u16 h) { return __uint_as_float(((unsigned)h) << 16); }
__device__ __forceinline__ float bflo(unsigned w) { return __uint_as_float(w << 16); }
__device__ __forceinline__ float bfhi(unsigned w) { return __uint_as_float(w & 0xffff0000u); }
typedef float f32x2_t __attribute__((ext_vector_type(2)));
typedef __bf16 bf16x2_t __attribute__((ext_vector_type(2)));
__device__ __forceinline__ unsigned pack2(float a, float b) {
  f32x2_t v = {a, b};
  bf16x2_t r = __builtin_convertvector(v, bf16x2_t);
  return __builtin_bit_cast(unsigned, r);
}
__device__ __forceinline__ u16 f2bf(float f) { return (u16)(pack2(f, f) & 0xffffu); }
__device__ __forceinline__ float sigm(float x) { return __builtin_amdgcn_rcpf(1.f + __expf(-x)); }
__device__ __forceinline__ float silu(float x) { return x * __builtin_amdgcn_rcpf(1.f + __expf(-x)); }
__device__ __forceinline__ float gelu_t(float x) {
  float u = 0.7978845608028654f * (x + 0.044715f * x * x * x);
  float t = 1.f - 2.f * __builtin_amdgcn_rcpf(1.f + __expf(2.f * u));
  return 0.5f * x * (1.f + t);
}
__device__ __forceinline__ float rowmax4(float x) {
  auto r = __builtin_amdgcn_permlane16_swap(__float_as_uint(x), __float_as_uint(x), false, false);
  const float m = fmaxf(__uint_as_float(r[0]), __uint_as_float(r[1]));
  auto q = __builtin_amdgcn_permlane32_swap(__float_as_uint(m), __float_as_uint(m), false, false);
  return fmaxf(__uint_as_float(q[0]), __uint_as_float(q[1]));
}
__device__ __forceinline__ float wave_sum(float v) {
#pragma unroll
  for (int o = 32; o > 0; o >>= 1) v += __shfl_xor(v, o);
  return v;
}
__device__ __forceinline__ int grab(int* ctr, int* slot) {
  __syncthreads();
  if (threadIdx.x == 0) *slot = atomicAdd(ctr, 1);
  __syncthreads();
  return *slot;
}

__device__ __forceinline__ int otid() { int t = threadIdx.x; asm volatile("" : "+v"(t)); return t; }
#define XB_TMO      128
#define XB_XCNT(j)  (256  + 64 * (j))
#define XB_XSUB(j)  (1280 + 64 * (j))
#define XB_XGEN(j)  (2304 + 64 * (j))
#define XB_TOP      3328
#define XB_TOPGEN   3392
#define XCD_BAR_WORDS 3456
#define XB_SPIN_CAP (1u << 18)
#define LAS __attribute__((address_space(3)))

__device__ __forceinline__ unsigned xb_ld(unsigned* p)              { return __hip_atomic_load(p, __ATOMIC_RELAXED, __HIP_MEMORY_SCOPE_AGENT); }
__device__ __forceinline__ unsigned xb_add(unsigned* p, unsigned v) { return __hip_atomic_fetch_add(p, v, __ATOMIC_RELAXED, __HIP_MEMORY_SCOPE_AGENT); }
__device__ __forceinline__ unsigned xb_xcc_id() { return (unsigned)__builtin_amdgcn_s_getreg((3 << 11) | 20) & 0xFu; }
#define XB_SPIN(cond, bar) do { unsigned _sp = 0; while (cond) { __builtin_amdgcn_s_sleep(1); \
    if ((++_sp & 255u) == 0u) { if (xb_ld(&(bar)[XB_TMO])) break; if (_sp > XB_SPIN_CAP) { atomicAdd(&(bar)[XB_TMO], 1u); break; } } } } while (0)

struct XcdBarrier {
    unsigned* bar; unsigned x;
    volatile LAS unsigned* st;
};

__device__ __forceinline__ XcdBarrier xcd_barrier_post(unsigned* bar, volatile LAS unsigned* st) {
    XcdBarrier b; b.bar = bar; b.x = xb_xcc_id(); b.st = st;
    if (threadIdx.x == 0) (void)xb_add(&bar[XB_XCNT(b.x)], 1u);
    return b;
}
__device__ __forceinline__ void xcd_barrier_complete(unsigned* bar, unsigned x, unsigned& nloc, unsigned& nx) {
    const unsigned G = gridDim.x * gridDim.y * gridDim.z;
    unsigned sum, cnt, mine, sp = 0u;
    for (;;) {
        sum = 0u; cnt = 0u; mine = 0u;
#pragma unroll
        for (unsigned j = 0; j < 16; ++j) { const unsigned c = xb_ld(&bar[XB_XCNT(j)]); sum += c; cnt += (c > 0u) ? 1u : 0u; mine = (j == x) ? c : mine; }
        if (sum == G) break;
        __builtin_amdgcn_s_sleep(1);
        if ((++sp & 255u) == 0u) { if (xb_ld(&bar[XB_TMO])) break; if (sp > XB_SPIN_CAP) { atomicAdd(&bar[XB_TMO], 1u); break; } }
    }
    nloc = mine > 0u ? mine : 1u; nx = cnt > 0u ? cnt : 1u;
}

__device__ __forceinline__ void xcd_barrier(const XcdBarrier& b) {
    asm volatile("s_waitcnt vmcnt(0)" ::: "memory");
    __syncthreads();
    if (threadIdx.x == 0) {
        unsigned* bar = b.bar;
        __builtin_amdgcn_s_waitcnt(0);
        unsigned nloc = b.st[0], nx = b.st[1];
        if (nloc == 0u) { xcd_barrier_complete(bar, b.x, nloc, nx); b.st[0] = nloc; b.st[1] = nx; }
        const unsigned old = xb_add(&bar[XB_XSUB(b.x)], 1u);
        const unsigned gen = old / nloc;
        if (old + 1u == (gen + 1u) * nloc) {
            __builtin_amdgcn_fence(__ATOMIC_RELEASE, "agent");
            asm volatile("s_waitcnt vmcnt(0)" ::: "memory");
            const unsigned og = xb_add(&bar[XB_TOP], 1u);
            const unsigned tg = og / nx;
            if (og + 1u == (tg + 1u) * nx) xb_add(&bar[XB_TOPGEN], 1u);
            else XB_SPIN(xb_ld(&bar[XB_TOPGEN]) == tg, bar);
            __builtin_amdgcn_fence(__ATOMIC_ACQUIRE, "agent");
            xb_add(&bar[XB_XGEN(b.x)], 1u);
            asm volatile("s_waitcnt vmcnt(0)" ::: "memory");
        } else {
            XB_SPIN(xb_ld(&bar[XB_XGEN(b.x)]) == gen, bar);
            __builtin_amdgcn_fence(__ATOMIC_ACQUIRE, "agent");
            asm volatile("s_waitcnt vmcnt(0)" ::: "memory");
        }
    }
    __syncthreads();
}

__device__ __forceinline__ void gbar(unsigned* cnt, unsigned& target) {
  asm volatile("s_waitcnt vmcnt(0)" ::: "memory");
  __syncthreads();
  target += gridDim.x;
  if (threadIdx.x == 0) {
    __builtin_amdgcn_fence(__ATOMIC_RELEASE, "agent");
    asm volatile("s_waitcnt vmcnt(0)" ::: "memory");
    __hip_atomic_fetch_add(cnt, 1u, __ATOMIC_RELAXED, __HIP_MEMORY_SCOPE_AGENT);
    while (__hip_atomic_load(cnt, __ATOMIC_RELAXED, __HIP_MEMORY_SCOPE_AGENT) < target) __builtin_amdgcn_s_sleep(1);
    __builtin_amdgcn_fence(__ATOMIC_ACQUIRE, "agent");
    asm volatile("s_waitcnt vmcnt(0)" ::: "memory");
  }
  __syncthreads();
}
__device__ __forceinline__ const float* x_in_row(const Params& p, int layer, int unit, int t) {
  size_t off = (unit == 0) ? (size_t)t * DM : (size_t)((unit - 1) * 4096 + t) * DM;
  if (layer == 0) return ((unit == 0) ? p.in[0] : p.in[1]) + off;
  return p.out + ((unit == 0) ? 0 : OY_S) + off;
}
__device__ __forceinline__ float* y_out_row(const Params& p, int unit, int t) {
  size_t off = (unit == 0) ? (size_t)t * DM : (size_t)((unit - 1) * 4096 + t) * DM;
  return p.out + ((unit == 0) ? 0 : OY_S) + off;
}

constexpr int LDT = 40;
__device__ __forceinline__ void gemm_tile(const u16* __restrict__ A, size_t lda, const u16* __restrict__ B, size_t ldb,
                                          int K, f32x4 (&acc)[4][4], u16* sm) {
  const int tid = otid() & 255, lane = tid & 63, wid = tid >> 6, wr = wid >> 1, wc = wid & 1, fr = lane & 15, fq = lane >> 4;
  u16* As = sm;
  u16* Bs = sm + 2 * 128 * LDT;
  const int lrow = tid >> 2, lkc = (tid & 3) * 8;
  const u16* Ag = A + (size_t)lrow * lda + lkc;
  const u16* Bg = B + (size_t)lrow * ldb + lkc;
  const size_t a64 = 64 * lda, b64 = 64 * ldb;
  uint4 ra0 = *(const uint4*)(Ag), ra1 = *(const uint4*)(Ag + a64);
  uint4 rb0 = *(const uint4*)(Bg), rb1 = *(const uint4*)(Bg + b64);
  __syncthreads();
  *(uint4*)(As + lrow * LDT + lkc) = ra0;
  *(uint4*)(As + (lrow + 64) * LDT + lkc) = ra1;
  *(uint4*)(Bs + lrow * LDT + lkc) = rb0;
  *(uint4*)(Bs + (lrow + 64) * LDT + lkc) = rb1;
  __syncthreads();
  const int nk = K >> 5;
  for (int kt = 0; kt < nk; ++kt) {
    const int cur = kt & 1;
    const bool more = (kt + 1 < nk);
    if (more) {
      const int ko = (kt + 1) * 32;
      ra0 = *(const uint4*)(Ag + ko); ra1 = *(const uint4*)(Ag + a64 + ko);
      rb0 = *(const uint4*)(Bg + ko); rb1 = *(const uint4*)(Bg + b64 + ko);
    }
    const u16* as = As + cur * 128 * LDT;
    const u16* bs = Bs + cur * 128 * LDT;
    bf16x8 af[4], bfg[4];
#pragma unroll
    for (int i = 0; i < 4; ++i) {
      af[i] = *(const bf16x8*)(as + (wr * 64 + i * 16 + fr) * LDT + fq * 8);
      bfg[i] = *(const bf16x8*)(bs + (wc * 64 + i * 16 + fr) * LDT + fq * 8);
    }
#pragma unroll
    for (int ni = 0; ni < 4; ++ni)
#pragma unroll
      for (int mi = 0; mi < 4; ++mi)
        acc[ni][mi] = __builtin_amdgcn_mfma_f32_16x16x32_bf16(bfg[ni], af[mi], acc[ni][mi], 0, 0, 0);
    if (more) {
      u16* aw = As + (cur ^ 1) * 128 * LDT;
      u16* bw = Bs + (cur ^ 1) * 128 * LDT;
      *(uint4*)(aw + lrow * LDT + lkc) = ra0;
      *(uint4*)(aw + (lrow + 64) * LDT + lkc) = ra1;
      *(uint4*)(bw + lrow * LDT + lkc) = rb0;
      *(uint4*)(bw + (lrow + 64) * LDT + lkc) = rb1;
    }
    __syncthreads();
  }
}
#define ACC_ZERO(acc) _Pragma("unroll") for (int _a = 0; _a < 4; ++_a) _Pragma("unroll") for (int _b = 0; _b < 4; ++_b) acc[_a][_b] = f32x4{0.f, 0.f, 0.f, 0.f}
#define EPI_IDX const int tid_ = otid() & 255, lane_ = tid_ & 63, wid_ = tid_ >> 6, wr_ = wid_ >> 1, wc_ = wid_ & 1, fr_ = lane_ & 15, fq_ = lane_ >> 4
#define EPI_ROW(mi) (wr_ * 64 + (mi) * 16 + fr_)
#define EPI_COL(ni) (wc_ * 64 + (ni) * 16 + fq_ * 4)


__device__ __forceinline__ int lds_byte2(int r, int c) {
  int st = (r >> 4) * 2 + (c >> 5), ob = (r & 15) * 64 + (c & 31) * 2;
  return st * 1024 + (ob ^ (((ob >> 9) & 1) << 5));
}
__device__ __forceinline__ void stage_rc2(int b, int& R, int& C) {
  int st = b >> 10, sb = b & 1023, swz = sb ^ (((sb >> 9) & 1) << 5);
  R = (st >> 1) * 16 + swz / 64;
  C = (st & 1) * 32 + (swz % 64) / 2;
}
using i32x4 = __attribute__((ext_vector_type(4))) int;
template <int BN>
__device__ __forceinline__ void gemm256(const u16* __restrict__ A, int lda, const u16* __restrict__ B, int ldb, int K,
                                        f32x4 (&acc)[(BN == 256) ? 8 : 4][4], char* shm) {
  constexpr int MT = (BN == 256) ? 8 : 4, WM = MT * 16;
  constexpr int TA = 256 * 64 * 2, TB = BN * 64 * 2, STAGE = TA + TB;
  constexpr int GLA = 4, GLB = TB / 8192;
  const int tid = otid(), wid = tid >> 6, lane = tid & 63, fr = lane & 15, fq = lane >> 4;
  const int wr = (BN == 256) ? (wid >> 2) : (wid >> 1), wc = (BN == 256) ? (wid & 3) : (wid & 1);
  int oa[GLA], ob[GLB];
#pragma unroll
  for (int i = 0; i < GLA; ++i) { int R, C; stage_rc2(wid * 1024 + i * 8192 + lane * 16, R, C); oa[i] = R * lda + C; }
#pragma unroll
  for (int i = 0; i < GLB; ++i) { int R, C; stage_rc2(wid * 1024 + i * 8192 + lane * 16, R, C); ob[i] = R * ldb + C; }
  i32x4 sa[GLA], sb[GLB];
  char* wbase = shm + wid * 1024 + lane * 16;
#define G_ISSUE(kt) do { _Pragma("unroll") for (int i = 0; i < GLA; ++i) sa[i] = *(const i32x4*)(A + oa[i] + (kt) * 64); \
                         _Pragma("unroll") for (int i = 0; i < GLB; ++i) sb[i] = *(const i32x4*)(B + ob[i] + (kt) * 64); } while (0)
#define G_WRITE(buf) do { _Pragma("unroll") for (int i = 0; i < GLA; ++i) *(i32x4*)(wbase + (buf) * STAGE + i * 8192) = sa[i]; \
                          _Pragma("unroll") for (int i = 0; i < GLB; ++i) *(i32x4*)(wbase + (buf) * STAGE + TA + i * 8192) = sb[i]; } while (0)
  const int nt = K >> 6;
  G_ISSUE(0);
  __syncthreads();
  G_WRITE(0);
  G_ISSUE(1);
  __syncthreads();
  for (int t = 0; t < nt; ++t) {
    const int cur = t & 1;
    if (t + 1 < nt) G_WRITE(cur ^ 1);
    if (t + 2 < nt) G_ISSUE(t + 2);
    const char* sA = shm + cur * STAGE;
    const char* sB = sA + TA;
#pragma unroll
    for (int ks = 0; ks < 2; ++ks) {
      bf16x8 At[MT], Bf[4];
#pragma unroll
      for (int m = 0; m < MT; ++m) At[m] = *(const bf16x8*)(sA + lds_byte2(wr * WM + m * 16 + fr, ks * 32 + fq * 8));
#pragma unroll
      for (int n = 0; n < 4; ++n) Bf[n] = *(const bf16x8*)(sB + lds_byte2(wc * 64 + n * 16 + fr, ks * 32 + fq * 8));
#pragma unroll
      for (int m = 0; m < MT; ++m)
#pragma unroll
        for (int n = 0; n < 4; ++n) acc[m][n] = __builtin_amdgcn_mfma_f32_16x16x32_bf16(Bf[n], At[m], acc[m][n], 0, 0, 0);
    }
    __syncthreads();
  }
#undef G_ISSUE
#undef G_WRITE
}

template <int BN, class SegFn, class EndFn>
__device__ __forceinline__ void gemm256_stream(int nseg, SegFn seg, EndFn endf, f32x4 (&acc)[(BN == 256) ? 8 : 4][4], char* shm) {
  constexpr int MT = (BN == 256) ? 8 : 4, WM = MT * 16;
  constexpr int TA = 256 * 64 * 2, TB = BN * 64 * 2, STAGE = 65536;
  constexpr int GLA = 4, GLB = TB / 8192;
  const int tid = otid(), wid = tid >> 6, lane = tid & 63, fr = lane & 15, fq = lane >> 4;
  const int wr = (BN == 256) ? (wid >> 2) : (wid >> 1), wc = (BN == 256) ? (wid & 3) : (wid & 1);
  int total = 0;
  for (int s_ = 0; s_ < nseg; ++s_) { const u16 *a_, *b_; int la_, lb_, nk_; seg(s_, a_, la_, b_, lb_, nk_); total += nk_; }
  int ps = 0, pk = 0, pnk, plda, pldb;
  const u16 *pA, *pB;
  seg(0, pA, plda, pB, pldb, pnk);
  unsigned oa[GLA], ob[GLB];
#define S_OFFS() do { _Pragma("unroll") for (int i = 0; i < GLA; ++i) { int R_, C_; stage_rc2(wid * 1024 + i * 8192 + lane * 16, R_, C_); \
      oa[i] = (unsigned)(R_ * plda + C_) * 2u; if (i < GLB) ob[i] = (unsigned)(R_ * pldb + C_) * 2u; } } while (0)
  S_OFFS();
  int cs = 0, ck = 0, cnk = pnk;
  char* wbase = shm + (wid & 7) * 1024;
#define S_STAGE(buf) do { \
    const char* ak_ = (const char*)pA + pk * 128; \
    const char* bk_ = (const char*)pB + pk * 128; \
    _Pragma("unroll") for (int i = 0; i < GLA; ++i) \
      __builtin_amdgcn_global_load_lds((const unsigned*)(ak_ + oa[i]), (unsigned*)(wbase + (buf) * STAGE + i * 8192), 16, 0, 0); \
    _Pragma("unroll") for (int i = 0; i < GLB; ++i) \
      __builtin_amdgcn_global_load_lds((const unsigned*)(bk_ + ob[i]), (unsigned*)(wbase + (buf) * STAGE + TA + i * 8192), 16, 0, 0); \
    if (++pk == pnk) { pk = 0; if (++ps < nseg) { seg(ps, pA, plda, pB, pldb, pnk); S_OFFS(); } } } while (0)
  __syncthreads();
  S_STAGE(0);
  asm volatile("s_waitcnt vmcnt(0)" ::: "memory");
  __syncthreads();
#define S_BODY(cur) do { \
    if (g + 1 < total) S_STAGE((cur) ^ 1); \
    const char* sA = shm + (cur) * STAGE; \
    const char* sB = sA + TA; \
    _Pragma("unroll") for (int ks = 0; ks < 2; ++ks) { \
      bf16x8 At[MT], Bf[4]; \
      _Pragma("unroll") for (int m = 0; m < MT; ++m) At[m] = *(const bf16x8*)(sA + (lds_byte2(wr * WM + m * 16 + fr, ks * 32 + fq * 8) & 0x7FFF)); \
      _Pragma("unroll") for (int n = 0; n < 4; ++n) Bf[n] = *(const bf16x8*)(sB + (lds_byte2(wc * 64 + n * 16 + fr, ks * 32 + fq * 8) & 0x7FFF)); \
      _Pragma("unroll") for (int m = 0; m < MT; ++m) \
        _Pragma("unroll") for (int n = 0; n < 4; ++n) acc[m][n] = __builtin_amdgcn_mfma_f32_16x16x32_bf16(Bf[n], At[m], acc[m][n], 0, 0, 0); \
      __builtin_amdgcn_sched_group_barrier(0x100, 6, 0); \
      _Pragma("unroll") for (int m = 0; m < MT; ++m) { \
        __builtin_amdgcn_sched_group_barrier(0x008, 4, 0); \
        if (m + 2 < MT) __builtin_amdgcn_sched_group_barrier(0x100, 1, 0); \
      } \
    } \
    if (++ck == cnk) { \
      endf(cs, acc); \
      _Pragma("unroll") for (int m = 0; m < MT; ++m) \
        _Pragma("unroll") for (int n = 0; n < 4; ++n) acc[m][n] = f32x4{0.f, 0.f, 0.f, 0.f}; \
      ck = 0; \
      if (++cs < nseg) { const u16 *a_, *b_; int la_, lb_; seg(cs, a_, la_, b_, lb_, cnk); } \
    } \
    asm volatile("s_waitcnt vmcnt(0)" ::: "memory"); \
    __syncthreads(); \
    ++g; } while (0)
  for (int g = 0; g < total;) {
    S_BODY(0);
    if (g < total) S_BODY(1);
  }
#undef S_BODY
#undef S_STAGE
#undef S_OFFS
}

#define EPI256(BN_) const int tid_ = otid(), wid_ = tid_ >> 6, lane_ = tid_ & 63, fr_ = lane_ & 15, fq_ = lane_ >> 4, \
    wr_ = ((BN_) == 256) ? (wid_ >> 2) : (wid_ >> 1), wc_ = ((BN_) == 256) ? (wid_ & 3) : (wid_ & 1), wm_ = ((BN_) == 256) ? 128 : 64
#define E256_ROW(m) (wr_ * wm_ + (m) * 16 + fr_)
#define E256_COL(n) (wc_ * 64 + (n) * 16 + fq_ * 4)

__device__ __forceinline__ void conv_transpose(const float* __restrict__ src, int K, int N, u16* __restrict__ dst, float* tile) {
  const int tid = otid(), lane = tid & 63, w = tid >> 6;
  const int ntn = N >> 8, nt = (K >> 6) * ntn;
  for (int t = blockIdx.x; t < nt; t += gridDim.x) {
    const int k0 = (t / ntn) << 6, n0 = (t % ntn) << 8;
    const float* sp = src + (size_t)(k0 + w * 8) * N + n0 + lane * 4;
    const float4 v0 = *(const float4*)(sp), v1 = *(const float4*)(sp + (size_t)N), v2 = *(const float4*)(sp + (size_t)2 * N), v3 = *(const float4*)(sp + (size_t)3 * N);
    const float4 v4 = *(const float4*)(sp + (size_t)4 * N), v5 = *(const float4*)(sp + (size_t)5 * N), v6 = *(const float4*)(sp + (size_t)6 * N), v7 = *(const float4*)(sp + (size_t)7 * N);
    __syncthreads();
    float* tw = tile + (w * 8) * 260 + lane * 4;
    *(float4*)(tw) = v0; *(float4*)(tw + 260) = v1; *(float4*)(tw + 520) = v2; *(float4*)(tw + 780) = v3;
    *(float4*)(tw + 1040) = v4; *(float4*)(tw + 1300) = v5; *(float4*)(tw + 1560) = v6; *(float4*)(tw + 1820) = v7;
    __syncthreads();
    const int kg = tid & 7;
#pragma unroll
    for (int i = 0; i < 4; ++i) {
      const int n = (tid >> 3) + i * 64;
      const float* tp = tile + (kg * 8) * 260 + n;
      uint4 o;
      o.x = pack2(tp[0], tp[260]); o.y = pack2(tp[2 * 260], tp[3 * 260]);
      o.z = pack2(tp[4 * 260], tp[5 * 260]); o.w = pack2(tp[6 * 260], tp[7 * 260]);
      *(uint4*)(dst + (size_t)(n0 + n) * K + k0 + kg * 8) = o;
    }
  }
}

__device__ __forceinline__ void s5_item(const Params& p, int layer, int rd, int bi, int pass, u16* smem) {
  const int tid = otid(), lane = tid & 63, wid = tid >> 6, fr = lane & 15, fq = lane >> 4;
  const int w = bi * 8 + wid;
  const int lu = w >> 10, rem = w & 1023, d = rem & 1, g = (rem >> 1) & 31, ss = rem >> 6;
  const int unit = rd * 3 + lu;
  const bool ctx = (unit == 0);
  const int L = ctx ? 256 : 4096;
  const int seq = ctx ? ss : 0, seg = ctx ? 0 : ss;
  const int rowbase = lu * 4096 + seq * L;
  const u16* proj = (const u16*)(p.ws + OFF_PROJ);
  float* bul = (float*)smem + wid * 2560;
  u16* Hs = smem + 40960 + wid * (16 * 136);
  const int pg = ((layer * 2 + d) * 32 + g);
  const float step = __expf(p.in[17][pg]);
  float lbr, lbi;
  {
    const float lre = p.in[15][pg * 64 + lane], lim = p.in[16][pg * 64 + lane];
    const float mag = __expf(lre * step);
    lbr = mag * __cosf(lim * step); lbi = mag * __sinf(lim * step);
  }
  bf16x8 bbf[8], bbl[8];
#pragma unroll
  for (int q = 0; q < 4; ++q) {
    const int n = q * 16 + fr;
    const float lre = p.in[15][pg * 64 + n], lim = p.in[16][pg * 64 + n];
    const float mag = __expf(lre * step);
    const float br_ = mag * __cosf(lim * step), bi_ = mag * __sinf(lim * step);
    const float nr = br_ - 1.f, den = lre * lre + lim * lim;
    const float fre = (nr * lre + bi_ * lim) / den, fim = (bi_ * lre - nr * lim) / den;
    const float* br = p.in[18] + ((size_t)pg * 64 + n) * 16 + (fq & 1) * 8;
    const float* bim = p.in[19] + ((size_t)pg * 64 + n) * 16 + (fq & 1) * 8;
    const float msk = (fq < 2) ? 1.f : 0.f;
    u32x4 ure, uim, lre_, lim_;
#pragma unroll
    for (int i = 0; i < 4; ++i) {
      const float a0 = br[2 * i] * msk, b0 = bim[2 * i] * msk, a1 = br[2 * i + 1] * msk, b1 = bim[2 * i + 1] * msk;
      const float r0 = fre * a0 - fim * b0, r1 = fre * a1 - fim * b1, m0 = fre * b0 + fim * a0, m1 = fre * b1 + fim * a1;
      ure[i] = pack2(r0, r1);
      uim[i] = pack2(m0, m1);
      lre_[i] = pack2(r0 - bflo(ure[i]), r1 - bfhi(ure[i]));
      lim_[i] = pack2(m0 - bflo(uim[i]), m1 - bfhi(uim[i]));
    }
    bbf[q] = __builtin_bit_cast(bf16x8, ure);
    bbf[4 + q] = __builtin_bit_cast(bf16x8, uim);
    bbl[q] = __builtin_bit_cast(bf16x8, lre_);
    bbl[4 + q] = __builtin_bit_cast(bf16x8, lim_);
  }
  float hr = 0.f, hi = 0.f;
  bf16x8 cf[4];
  u16* ysd = (u16*)(p.ws + OFF_YS) + (size_t)d * RR * 512;
  float* loc = (float*)(p.ws + OFF_S5LOC);
  if (pass == 2) {
    if (!ctx) {
      const size_t si = ((((size_t)(unit - 1) * 2 + layer) * 2 + d) * 32 + g) * 64 + lane;
      hr = p.in[5][si]; hi = p.in[6][si];
    }
    float ar = lbr, ai = lbi;
#pragma unroll
    for (int i = 0; i < 8; ++i) { float t = ar * ar - ai * ai; ai = 2.f * ar * ai; ar = t; }
    for (int i = 0; i < seg; ++i) {
      const int wi = (lu << 10) + (i << 6) + (g << 1) + d;
      const float lr_ = loc[(size_t)wi * 128 + lane], li_ = loc[(size_t)wi * 128 + 64 + lane];
      const float t = ar * hr - ai * hi + lr_;
      hi = ar * hi + ai * hr + li_;
      hr = t;
    }
    const float* cre = p.in[20] + ((size_t)pg * 16 + fr) * 64;
    const float* cim = p.in[21] + ((size_t)pg * 16 + fr) * 64;
#pragma unroll
    for (int ks = 0; ks < 4; ++ks) {
      const float* src = (ks < 2) ? (cre + ks * 32 + fq * 8) : (cim + (ks - 2) * 32 + fq * 8);
      const float sg = (ks < 2) ? 1.f : -1.f;
      u32x4 uc;
#pragma unroll
      for (int i = 0; i < 4; ++i) uc[i] = pack2(sg * src[2 * i], sg * src[2 * i + 1]);
      cf[ks] = __builtin_bit_cast(bf16x8, uc);
    }
  }
  auto load_u = [&](int sbg) -> u32x4 {
    const int pos = seg * 256 + sbg * 16 + fr;
    const int l = d ? (L - 1 - pos) : pos;
    u32x4 v = *(const u32x4*)(proj + (size_t)(rowbase + l) * PS + C_UB + g * 16 + (fq & 1) * 8);
    if (fq >= 2) v = u32x4{0u, 0u, 0u, 0u};
    return v;
  };
  u32x4 unext = load_u(0);
  for (int sbg = 0; sbg < 16; ++sbg) {
    const bf16x8 uf = __builtin_bit_cast(bf16x8, unext);
    if (sbg + 1 < 16) unext = load_u(sbg + 1);
#pragma unroll
    for (int nt = 0; nt < 8; ++nt) {
      f32x4 a = f32x4{0.f, 0.f, 0.f, 0.f};
      a = __builtin_amdgcn_mfma_f32_16x16x32_bf16(uf, bbl[nt], a, 0, 0, 0);
      a = __builtin_amdgcn_mfma_f32_16x16x32_bf16(uf, bbf[nt], a, 0, 0, 0);
      *(f32x4*)(bul + (nt * 16 + fr) * 20 + fq * 4) = a;
    }
    asm volatile("s_waitcnt lgkmcnt(0)" ::: "memory"); __builtin_amdgcn_wave_barrier();
    float bre[16], bim_[16];
#pragma unroll
    for (int k = 0; k < 4; ++k) {
      const f32x4 x = *(const f32x4*)(bul + lane * 20 + k * 4), y = *(const f32x4*)(bul + (64 + lane) * 20 + k * 4);
      bre[4 * k] = x[0]; bre[4 * k + 1] = x[1]; bre[4 * k + 2] = x[2]; bre[4 * k + 3] = x[3];
      bim_[4 * k] = y[0]; bim_[4 * k + 1] = y[1]; bim_[4 * k + 2] = y[2]; bim_[4 * k + 3] = y[3];
    }
    asm volatile("s_waitcnt lgkmcnt(0)" ::: "memory"); __builtin_amdgcn_wave_barrier();
#pragma unroll
    for (int s2 = 0; s2 < 16; ++s2) {
      const float t = lbr * hr - lbi * hi + bre[s2];
      hi = lbr * hi + lbi * hr + bim_[s2];
      hr = t;
      if (pass == 2) { Hs[s2 * 136 + lane] = f2bf(hr); Hs[s2 * 136 + 64 + lane] = f2bf(hi); }
    }
    if (pass == 2) {
      asm volatile("s_waitcnt lgkmcnt(0)" ::: "memory"); __builtin_amdgcn_wave_barrier();
      f32x4 ya = f32x4{0.f, 0.f, 0.f, 0.f};
#pragma unroll
      for (int ks = 0; ks < 4; ++ks) {
        const bf16x8 hf = *(const bf16x8*)(Hs + fr * 136 + ks * 32 + fq * 8);
        ya = __builtin_amdgcn_mfma_f32_16x16x32_bf16(hf, cf[ks], ya, 0, 0, 0);
      }
#pragma unroll
      for (int j = 0; j < 4; ++j) {
        const int pos = seg * 256 + sbg * 16 + fq * 4 + j;
        const int l = d ? (L - 1 - pos) : pos;
        ysd[(size_t)(rowbase + l) * 512 + g * 16 + fr] = f2bf(ya[j]);
      }
      asm volatile("s_waitcnt lgkmcnt(0)" ::: "memory"); __builtin_amdgcn_wave_barrier();
    }
  }
  if (pass == 1) {
    loc[(size_t)w * 128 + lane] = hr;
    loc[(size_t)w * 128 + 64 + lane] = hi;
  } else if (ctx) {
    const size_t oi = ((((size_t)seq * 2 + layer) * 2 + d) * 32 + g) * 64 + lane;
    p.out[OS5R + oi] = hr;
    p.out[OS5I + oi] = hi;
  }
}

__device__ __forceinline__ void hgrnA_item(const Params& p, int layer, int gc, int h, char* shm) {
  const int tid = otid(), lane = tid & 63, w = tid >> 6, fr = lane & 15, fq = lane >> 4;
  const int d = tid & 127, tq = tid >> 7;
  const u16* proj = (const u16*)(p.ws + OFF_PROJ);
  u16* Qm = (u16*)shm;
  u16* Km = (u16*)(shm + 17408);
  u16* KlT = (u16*)(shm + 34816);
  u16* VT = (u16*)(shm + 53248);
  u16* Pm = (u16*)(shm + 71680);
  float* tot = (float*)(shm + 80896);
  const int rowb = gc * 64;
  for (int dir = 0; dir < 2; ++dir) {
    float lb = 0.f;
    if (layer == 1) {
      const int ci = dir * 512 + h * 128 + d;
      const float l0 = p.in[27][ci], l1 = p.in[27][1024 + ci];
      lb = 1.f / (1.f + __expf(l0 - l1));
    }
    float cl[16], kk[16], qv[16];
    float c = 0.f;
    const int zc = (dir ? C_ZB : C_ZF) + h * 128 + d;
    u16 rz[16], rq[16], rvv[16];
#pragma unroll
    for (int i = 0; i < 16; ++i) {
      const int t = tq * 16 + i;
      const size_t ro = (size_t)(rowb + (dir ? 63 - t : t)) * PS;
      rz[i] = proj[ro + zc];
      rq[i] = proj[ro + C_QD + h * 128 + d];
      rvv[i] = proj[ro + C_ID + h * 128 + d];
    }
    __builtin_amdgcn_sched_barrier(0);
    __syncthreads();
#pragma unroll
    for (int i = 0; i < 16; ++i) {
      const int t = tq * 16 + i;
      const float z = bf2f(rz[i]);
      const float f = lb + (1.f - lb) * sigm(z);
      kk[i] = 1.f - f;
      c += __logf(fmaxf(f, 1e-30f));
      cl[i] = c;
      qv[i] = bf2f(rq[i]);
      VT[d * 72 + t] = rvv[i];
    }
    tot[tq * 128 + d] = c;
    __syncthreads();
    const float t0 = tot[d], t1 = tot[128 + d], t2 = tot[256 + d], t3 = tot[384 + d];
    const float off = (tq == 0) ? 0.f : (tq == 1) ? t0 : (tq == 2) ? (t0 + t1) : (t0 + t1 + t2);
    const float mref = t0 + t1, last = t0 + t1 + t2 + t3;
    u16* qib = (u16*)(p.ws + OFF_QIB) + (size_t)dir * RR * 512;
#pragma unroll
    for (int i = 0; i < 16; ++i) {
      const int t = tq * 16 + i;
      const int row = rowb + (dir ? 63 - t : t);
      const float cum = off + cl[i];
      qib[(size_t)row * 512 + h * 128 + d] = f2bf(qv[i] * __expf(cum));
      Qm[t * 136 + d] = f2bf(qv[i] * __expf(fminf(cum - mref, 80.f)));
      Km[t * 136 + d] = f2bf(kk[i] * __expf(fminf(mref - cum, 80.f)));
      KlT[d * 72 + t] = f2bf(kk[i] * __expf(last - cum));
    }
    if (tq == 0) ((float*)(p.ws + OFF_DEC))[((size_t)(dir * 192 + gc) * 4 + h) * 128 + d] = __expf(last);
    __syncthreads();
    {
      const int mt = w >> 1;
#pragma unroll
      for (int nn = 0; nn < 2; ++nn) {
        const int nt = (w & 1) * 2 + nn;
        f32x4 a = f32x4{0.f, 0.f, 0.f, 0.f};
#pragma unroll
        for (int ks = 0; ks < 4; ++ks) {
          const bf16x8 mf = *(const bf16x8*)(Qm + (mt * 16 + fr) * 136 + ks * 32 + fq * 8);
          const bf16x8 nf = *(const bf16x8*)(Km + (nt * 16 + fr) * 136 + ks * 32 + fq * 8);
          a = __builtin_amdgcn_mfma_f32_16x16x32_bf16(nf, mf, a, 0, 0, 0);
        }
        const int t = mt * 16 + fr, s0 = nt * 16 + fq * 4;
        const float p0 = (s0 + 0 <= t) ? a[0] : 0.f, p1 = (s0 + 1 <= t) ? a[1] : 0.f;
        const float p2 = (s0 + 2 <= t) ? a[2] : 0.f, p3 = (s0 + 3 <= t) ? a[3] : 0.f;
        *(uint2*)(Pm + t * 72 + s0) = uint2{pack2(p0, p1), pack2(p2, p3)};
      }
    }
    __syncthreads();
    {
      const int mt = w & 3, ntb = (w >> 2) * 4;
      u16* og = (u16*)(p.ws + OFF_OHG) + (size_t)dir * RR * 512;
      const int t = mt * 16 + fr;
      const int row = rowb + (dir ? 63 - t : t);
      bf16x8 mf0 = *(const bf16x8*)(Pm + t * 72 + fq * 8), mf1 = *(const bf16x8*)(Pm + t * 72 + 32 + fq * 8);
#pragma unroll
      for (int nn = 0; nn < 4; ++nn) {
        const int nt = ntb + nn;
        f32x4 a = f32x4{0.f, 0.f, 0.f, 0.f};
        const bf16x8 nf0 = *(const bf16x8*)(VT + (nt * 16 + fr) * 72 + fq * 8), nf1 = *(const bf16x8*)(VT + (nt * 16 + fr) * 72 + 32 + fq * 8);
        a = __builtin_amdgcn_mfma_f32_16x16x32_bf16(nf0, mf0, a, 0, 0, 0);
        a = __builtin_amdgcn_mfma_f32_16x16x32_bf16(nf1, mf1, a, 0, 0, 0);
        *(uint2*)(og + (size_t)row * 512 + h * 128 + nt * 16 + fq * 4) = uint2{pack2(a[0], a[1]), pack2(a[2], a[3])};
      }
    }
    {
      const int mt = w;
      u16* ds = (u16*)(p.ws + OFF_DS) + ((size_t)(dir * 192 + gc) * 4 + h) * 16384;
      const bf16x8 mf0 = *(const bf16x8*)(VT + (mt * 16 + fr) * 72 + fq * 8), mf1 = *(const bf16x8*)(VT + (mt * 16 + fr) * 72 + 32 + fq * 8);
#pragma unroll
      for (int nt = 0; nt < 8; ++nt) {
        f32x4 a = f32x4{0.f, 0.f, 0.f, 0.f};
        const bf16x8 nf0 = *(const bf16x8*)(KlT + (nt * 16 + fr) * 72 + fq * 8), nf1 = *(const bf16x8*)(KlT + (nt * 16 + fr) * 72 + 32 + fq * 8);
        a = __builtin_amdgcn_mfma_f32_16x16x32_bf16(nf0, mf0, a, 0, 0, 0);
        a = __builtin_amdgcn_mfma_f32_16x16x32_bf16(nf1, mf1, a, 0, 0, 0);
        *(uint2*)(ds + (size_t)(mt * 16 + fr) * 128 + nt * 16 + fq * 4) = uint2{pack2(a[0], a[1]), pack2(a[2], a[3])};
      }
    }
  }
  __syncthreads();
}

__device__ __forceinline__ void hgrnB2_item(const Params& p, int layer, int gc, int hp) {
  const int tid = otid(), lane = tid & 63, w = tid >> 6, fr = lane & 15, fq = lane >> 4;
  const int mt = w & 3, h = hp * 2 + (w >> 2);
  const size_t row = (size_t)gc * 64 + mt * 16 + fr;
  const u16* qib = (const u16*)(p.ws + OFF_QIB);
  const u16* dsb = (const u16*)(p.ws + OFF_DS);
  f32x4 acc[8];
#pragma unroll
  for (int nt = 0; nt < 8; ++nt) acc[nt] = f32x4{0.f, 0.f, 0.f, 0.f};
#pragma unroll
  for (int dir = 0; dir < 2; ++dir) {
    const u16* qrow = qib + ((size_t)dir * RR + row) * 512 + h * 128 + fq * 8;
    const u16* sT = dsb + ((size_t)(dir * 192 + gc) * 4 + h) * 16384 + (size_t)fr * 128 + fq * 8;
    bf16x8 mf[4];
#pragma unroll
    for (int ks = 0; ks < 4; ++ks) mf[ks] = *(const bf16x8*)(qrow + ks * 32);
    bf16x8 nfa[8], nfb[8];
#pragma unroll
    for (int nt = 0; nt < 8; ++nt) nfa[nt] = *(const bf16x8*)(sT + (size_t)nt * 16 * 128);
#pragma unroll
    for (int nt = 0; nt < 8; ++nt) nfb[nt] = *(const bf16x8*)(sT + (size_t)nt * 16 * 128 + 32);
    __builtin_amdgcn_sched_barrier(0);
#pragma unroll
    for (int nt = 0; nt < 8; ++nt) acc[nt] = __builtin_amdgcn_mfma_f32_16x16x32_bf16(nfa[nt], mf[0], acc[nt], 0, 0, 0);
#pragma unroll
    for (int nt = 0; nt < 8; ++nt) nfa[nt] = *(const bf16x8*)(sT + (size_t)nt * 16 * 128 + 64);
    __builtin_amdgcn_sched_barrier(0);
#pragma unroll
    for (int nt = 0; nt < 8; ++nt) acc[nt] = __builtin_amdgcn_mfma_f32_16x16x32_bf16(nfb[nt], mf[1], acc[nt], 0, 0, 0);
#pragma unroll
    for (int nt = 0; nt < 8; ++nt) nfb[nt] = *(const bf16x8*)(sT + (size_t)nt * 16 * 128 + 96);
    __builtin_amdgcn_sched_barrier(0);
#pragma unroll
    for (int nt = 0; nt < 8; ++nt) acc[nt] = __builtin_amdgcn_mfma_f32_16x16x32_bf16(nfa[nt], mf[2], acc[nt], 0, 0, 0);
#pragma unroll
    for (int nt = 0; nt < 8; ++nt) acc[nt] = __builtin_amdgcn_mfma_f32_16x16x32_bf16(nfb[nt], mf[3], acc[nt], 0, 0, 0);
  }
  const u16* og0 = (const u16*)(p.ws + OFF_OHG) + row * 512 + h * 128 + fq * 4;
  const u16* og1 = og0 + (size_t)RR * 512;
  float ss = 0.f;
  uint2 o0s[8], o1s[8];
#pragma unroll
  for (int nt = 0; nt < 8; ++nt) { o0s[nt] = *(const uint2*)(og0 + nt * 16); o1s[nt] = *(const uint2*)(og1 + nt * 16); }
  __builtin_amdgcn_sched_barrier(0);
#pragma unroll
  for (int nt = 0; nt < 8; ++nt) {
    const f32x4 a0 = f32x4{bflo(o0s[nt].x), bfhi(o0s[nt].x), bflo(o0s[nt].y), bfhi(o0s[nt].y)};
    const f32x4 a1 = f32x4{bflo(o1s[nt].x), bfhi(o1s[nt].x), bflo(o1s[nt].y), bfhi(o1s[nt].y)};
    acc[nt] += a0 + a1;
    ss += acc[nt][0] * acc[nt][0] + acc[nt][1] * acc[nt][1] + acc[nt][2] * acc[nt][2] + acc[nt][3] * acc[nt][3];
  }
  ss += __shfl_xor(ss, 16); ss += __shfl_xor(ss, 32);
  const float inv = rsqrtf(ss * (1.f / 128.f) + 1e-6f);
  const u16* proj = (const u16*)(p.ws + OFF_PROJ);
  u16* Z = (u16*)(p.ws + OFF_Z);
  float4 gns[8]; uint2 ggs[8];
#pragma unroll
  for (int nt = 0; nt < 8; ++nt) {
    const int e = nt * 16 + fq * 4;
    gns[nt] = *(const float4*)(p.in[28] + (size_t)layer * 128 + e);
    ggs[nt] = *(const uint2*)(proj + row * PS + C_GD + h * 128 + e);
  }
  __builtin_amdgcn_sched_barrier(0);
#pragma unroll
  for (int nt = 0; nt < 8; ++nt) {
    const int e = nt * 16 + fq * 4;
    const float4 gn = gns[nt];
    const uint2 gg = ggs[nt];
    const float r0 = acc[nt][0] * inv * gn.x * silu(bflo(gg.x)), r1 = acc[nt][1] * inv * gn.y * silu(bfhi(gg.x));
    const float r2 = acc[nt][2] * inv * gn.z * silu(bflo(gg.y)), r3 = acc[nt][3] * inv * gn.w * silu(bfhi(gg.y));
    *(uint2*)(Z + row * ZS + Z_D + h * 128 + e) = uint2{pack2(r0, r1), pack2(r2, r3)};
  }
}

__device__ __forceinline__ void attn_item(const Params& p, int unit, int lu, int seq, int head, int qb, u16* smem) {
  const int tid = otid(), lane = tid & 63, wid = tid >> 6, fr = lane & 15, fq = lane >> 4;
  const bool ctx = (unit == 0);
  const int L = ctx ? 256 : 4096;
  const int nkeys = ctx ? 256 : NKMAX;
  const int hkv = head >> 2;
  const int qrow0 = lu * 4096 + seq * L + qb * 256 + wid * 32;
  const u16* Qb = (const u16*)(p.ws + OFF_QB);
  const u16* Kg = (const u16*)(p.ws + OFF_KB) + ((size_t)lu * NKMAX + (ctx ? seq * 256 : 0)) * 256 + hkv * 128;
  const u16* Vg = (const u16*)(p.ws + OFF_VT) + (size_t)lu * 256 * NKMAX + (ctx ? (size_t)(seq * 2 + hkv) * 128 * 256 : (size_t)hkv * 128 * NKMAX);
  bf16x8 qf[2][4];
#pragma unroll
  for (int nt = 0; nt < 2; ++nt)
#pragma unroll
    for (int ks = 0; ks < 4; ++ks)
      qf[nt][ks] = *(const bf16x8*)(Qb + (size_t)(qrow0 + nt * 16 + fr) * 1024 + head * 128 + ks * 32 + fq * 8);
  f32x4 OT[8][2];
#pragma unroll
  for (int a = 0; a < 8; ++a) { OT[a][0] = f32x4{0.f, 0.f, 0.f, 0.f}; OT[a][1] = f32x4{0.f, 0.f, 0.f, 0.f}; }
  float mrun[2] = {0.f, 0.f}, lrun[2] = {0.f, 0.f};
  const int ntile = nkeys >> 6;
  uint4 rk0, rk1, rv0, rv1;
  const int kkey = tid >> 4, kdc = (tid & 15) * 8;
  const int vd = tid >> 3, vkc = (tid & 7) * 8;
#define ATT_ISSUE(kt_) do { \
    const u16* kp_ = Kg + (size_t)((kt_) * 64 + kkey) * 256 + kdc; \
    const u16* vp_ = Vg + (size_t)vd * nkeys + (kt_) * 64 + vkc; \
    rk0 = *(const uint4*)(kp_); rk1 = *(const uint4*)(kp_ + 32 * 256); \
    rv0 = *(const uint4*)(vp_); rv1 = *(const uint4*)(vp_ + (size_t)64 * nkeys); \
  } while (0)
#define ATT_WRITE(buf_) do { u16* ks_ = smem + (buf_) * 17920; u16* vs_ = ks_ + 64 * 136; \
    *(uint4*)(ks_ + (kkey) * 136 + kdc) = rk0; *(uint4*)(ks_ + (kkey + 32) * 136 + kdc) = rk1; \
    *(uint4*)(vs_ + (vd) * 72 + vkc) = rv0; *(uint4*)(vs_ + (vd + 64) * 72 + vkc) = rv1; } while (0)
  ATT_ISSUE(0);
  __syncthreads();
  ATT_WRITE(0);
  if (ntile > 1) ATT_ISSUE(1);
  __syncthreads();
  for (int kt = 0; kt < ntile; ++kt) {
    const u16* Ks = smem + (kt & 1) * 17920;
    const u16* Vs = Ks + 64 * 136;
    f32x4 ST[4][2];
#pragma unroll
    for (int a = 0; a < 4; ++a) {
      ST[a][0] = f32x4{-mrun[0], -mrun[0], -mrun[0], -mrun[0]};
      ST[a][1] = f32x4{-mrun[1], -mrun[1], -mrun[1], -mrun[1]};
    }
#pragma unroll
    for (int ks = 0; ks < 4; ++ks) {
#pragma unroll
      for (int mt = 0; mt < 4; ++mt) {
        const bf16x8 kf = *(const bf16x8*)(Ks + (mt * 16 + fr) * 136 + ks * 32 + fq * 8);
        ST[mt][0] = __builtin_amdgcn_mfma_f32_16x16x32_bf16(kf, qf[0][ks], ST[mt][0], 0, 0, 0);
        ST[mt][1] = __builtin_amdgcn_mfma_f32_16x16x32_bf16(kf, qf[1][ks], ST[mt][1], 0, 0, 0);
      }
    }
    u32x4 pfu[2][2];
#pragma unroll
    for (int nt = 0; nt < 2; ++nt) {
      float mx = fmaxf(fmaxf(ST[0][nt][0], ST[0][nt][1]), fmaxf(ST[0][nt][2], ST[0][nt][3]));
#pragma unroll
      for (int mt = 1; mt < 4; ++mt) mx = fmaxf(mx, fmaxf(fmaxf(ST[mt][nt][0], ST[mt][nt][1]), fmaxf(ST[mt][nt][2], ST[mt][nt][3])));
      mx = rowmax4(mx);
      const bool need = (kt == 0) || (mx > 8.f);
      if (__any(need)) {
        const float delta = need ? mx : 0.f;
        const float alpha = __builtin_amdgcn_exp2f(-delta);
        mrun[nt] += delta;
        lrun[nt] *= alpha;
#pragma unroll
        for (int mt = 0; mt < 4; ++mt) ST[mt][nt] -= delta;
#pragma unroll
        for (int dt = 0; dt < 8; ++dt) OT[dt][nt] *= alpha;
      }
      float ps = 0.f;
#pragma unroll
      for (int mt = 0; mt < 4; ++mt) {
        const float p0 = __builtin_amdgcn_exp2f(ST[mt][nt][0]), p1 = __builtin_amdgcn_exp2f(ST[mt][nt][1]);
        const float p2 = __builtin_amdgcn_exp2f(ST[mt][nt][2]), p3 = __builtin_amdgcn_exp2f(ST[mt][nt][3]);
        ps += (p0 + p1) + (p2 + p3);
        pfu[nt][mt >> 1][(mt & 1) * 2 + 0] = pack2(p0, p1);
        pfu[nt][mt >> 1][(mt & 1) * 2 + 1] = pack2(p2, p3);
      }
      lrun[nt] += ps;
    }
    if (kt + 1 < ntile) ATT_WRITE((kt + 1) & 1);
    if (kt + 2 < ntile) ATT_ISSUE(kt + 2);
#pragma unroll
    for (int kk = 0; kk < 2; ++kk) {
      const bf16x8 pf0 = __builtin_bit_cast(bf16x8, pfu[0][kk]), pf1 = __builtin_bit_cast(bf16x8, pfu[1][kk]);
#pragma unroll
      for (int dt = 0; dt < 8; ++dt) {
        const u16* vrow = Vs + (dt * 16 + fr) * 72 + kk * 32 + fq * 4;
        const uint2 v0 = *(const uint2*)(vrow), v1 = *(const uint2*)(vrow + 16);
        const bf16x8 vf = __builtin_bit_cast(bf16x8, (u32x4){v0.x, v0.y, v1.x, v1.y});
        OT[dt][0] = __builtin_amdgcn_mfma_f32_16x16x32_bf16(vf, pf0, OT[dt][0], 0, 0, 0);
        OT[dt][1] = __builtin_amdgcn_mfma_f32_16x16x32_bf16(vf, pf1, OT[dt][1], 0, 0, 0);
      }
    }
    __syncthreads();
  }
  const u16* proj = (const u16*)(p.ws + OFF_PROJ);
  u16* Z = (u16*)(p.ws + OFF_Z);
#pragma unroll
  for (int nt = 0; nt < 2; ++nt) {
    float lt = lrun[nt];
    lt += __shfl_xor(lt, 16); lt += __shfl_xor(lt, 32);
    const float inv = 1.f / lt;
    const size_t row = (size_t)(qrow0 + nt * 16 + fr);
    uint2 ggs[8];
#pragma unroll
    for (int dt = 0; dt < 8; ++dt) ggs[dt] = *(const uint2*)(proj + row * PS + C_GC + head * 128 + dt * 16 + fq * 4);
    __builtin_amdgcn_sched_barrier(0);
#pragma unroll
    for (int dt = 0; dt < 8; ++dt) {
      const int dd = head * 128 + dt * 16 + fq * 4;
      const uint2 gg = ggs[dt];
      const float o0 = OT[dt][nt][0] * inv * silu(bflo(gg.x)), o1 = OT[dt][nt][1] * inv * silu(bfhi(gg.x));
      const float o2 = OT[dt][nt][2] * inv * silu(bflo(gg.y)), o3 = OT[dt][nt][3] * inv * silu(bfhi(gg.y));
      *(uint2*)(Z + row * ZS + Z_C + dd) = uint2{pack2(o0, o1), pack2(o2, o3)};
    }
  }
  __syncthreads();
}

__global__ void __launch_bounds__(512) mega(Params p) {
  __shared__ __attribute__((aligned(1024))) char shm[131072];
  u16* smem = (u16*)shm;
  __shared__ int s_slot;
  __shared__ uint4 xb_words;
  if (threadIdx.x == 0) xb_words = make_uint4(0u, 0u, 0u, 0u);
  cg::grid_group grid = cg::this_grid();
  const int bid = blockIdx.x, nb = gridDim.x;
#define PHASE_IDS const int tid = otid(), lane = tid & 63, wid = tid >> 6; const size_t gtid = (size_t)bid * 512 + tid; const int gwave = bid * 8 + wid; const int gi = wid >> 2; u16* smg = smem + gi * 20480; (void)gi; (void)smg; (void)lane; (void)gtid; (void)gwave
  const size_t gthreads = (size_t)nb * 512;
  const int nwaves = nb * 8;
  char* ws = p.ws;
#define WinT ((u16*)(p.ws + OFF_WINT))
#define WpA ((u16*)(p.ws + OFF_WPA))
#define WpB ((u16*)(p.ws + OFF_WPB))
#define WpC ((u16*)(p.ws + OFF_WPC))
#define WpD ((u16*)(p.ws + OFF_WPD))
#define WoutT ((u16*)(p.ws + OFF_WOUT))
#define GluT ((u16*)(p.ws + OFF_GLU))
#define FWt ((u16*)(p.ws + OFF_FWT))
#define DftL ((u16*)(p.ws + OFF_DFTL))
#define DftS ((u16*)(p.ws + OFF_DFTS))
#define modp ((float*)(p.ws + OFF_MODP))
#define modb ((float*)(p.ws + OFF_MOD))
#define ctr ((int*)(p.ws + OFF_CTR))
#define hbuf ((u16*)(p.ws + OFF_H))
#define proj ((u16*)(p.ws + OFF_PROJ))
#define Z ((u16*)(p.ws + OFF_Z))
#define PQt ((u16*)(p.ws + OFF_PQT))
#define ys ((u16*)(p.ws + OFF_YS))
#define yb ((u16*)(p.ws + OFF_YB))
#define Qb ((u16*)(p.ws + OFF_QB))
#define Kb ((u16*)(p.ws + OFF_KB))
#define Vt ((u16*)(p.ws + OFF_VT))
#define mixed ((u16*)(p.ws + OFF_MIXED))
#define outb ((u16*)(p.ws + OFF_OUTB))

  {
  PHASE_IDS;
  if (bid == 0) for (int i = tid; i < 1024; i += 512) ctr[i] = 0;
  if (bid == 0) for (int i = tid; i < 4096; i += 512) ((unsigned*)(p.ws + OFF_XBAR))[i] = 0u;
  for (int l = 0; l < 2; ++l) {
    conv_transpose(p.in[13] + (size_t)l * 2048 * 15360, 2048, 15360, WinT + (size_t)l * 15360 * 2048, (float*)smem);
    conv_transpose(p.in[29] + (size_t)l * 512 * 2048, 512, 2048, WpA + (size_t)l * 2048 * 512, (float*)smem);
    conv_transpose(p.in[30] + (size_t)l * 512 * 2048, 512, 2048, WpB + (size_t)l * 2048 * 512, (float*)smem);
    conv_transpose(p.in[31] + (size_t)l * 1024 * 2048, 1024, 2048, WpC + (size_t)l * 2048 * 1024, (float*)smem);
    conv_transpose(p.in[32] + (size_t)l * 512 * 2048, 512, 2048, WpD + (size_t)l * 2048 * 512, (float*)smem);
    conv_transpose(p.in[33] + (size_t)l * 2048 * 2048, 2048, 2048, WoutT + (size_t)l * 2048 * 2048, (float*)smem);
    conv_transpose(p.in[23] + (size_t)l * 512 * 512, 512, 512, GluT + (size_t)l * 512 * 512, (float*)smem);
  }
  for (size_t idx = gtid; idx < (size_t)2048 * 4096; idx += gthreads) {
    const int k = (int)(idx >> 12), l = (int)(idx & 4095);
    const int m = (k * l) & 4095;
    const float a = (float)m * (6.283185307179586f / 4096.f);
    DftL[(size_t)k * 8192 + l] = f2bf(__cosf(a) * (1.f / 64.f));
    DftL[(size_t)k * 8192 + 4096 + l] = f2bf(-__sinf(a) * (1.f / 64.f));
  }
  for (size_t idx = gtid; idx < (size_t)256 * 256; idx += gthreads) {
    const int k = (int)(idx >> 8), l = (int)(idx & 255);
    const int m = (k * l) & 255;
    const float a = (float)m * (6.283185307179586f / 256.f);
    DftS[(size_t)k * 512 + l] = f2bf(__cosf(a) * (1.f / 16.f));
    DftS[(size_t)k * 512 + 256 + l] = f2bf(-__sinf(a) * (1.f / 16.f));
  }
  for (size_t idx = gtid; idx < (size_t)2 * 4 * 256 * 128; idx += gthreads) {
    const int c = (int)(idx & 127), n = (int)((idx >> 7) & 255), lg = (int)(idx >> 15);
    const float* w = p.in[14] + (size_t)lg * 128 * 128 + (n & 127);
    float acc = 0.f;
    for (int m = 0; m < 128; ++m) {
      const float a = (float)((m * c) & 127) * (6.283185307179586f / 128.f);
      const float tr = (n < 128) ? __cosf(a) : __sinf(a);
      acc += tr * w[(size_t)m * 128];
    }
    FWt[idx] = f2bf(acc * 0.08838834764831845f);
  }
  for (int it = bid; it < 384; it += nb) {
    const int layer = it / 192, rem = it % 192, cb = rem >> 4, kc = rem & 15;
    float* sc = (float*)smem;
    __syncthreads();
    for (int idx = tid; idx < 9 * 128; idx += 512) {
      const int u = idx >> 7, k = idx & 127;
      const float cv = (u == 0) ? p.in[8][kc * 128 + k] : p.in[2][(size_t)(u - 1) * 2048 + kc * 128 + k];
      sc[idx] = silu(cv);
    }
    __syncthreads();
    const int col = cb * 512 + tid;
    float a9[9];
#pragma unroll
    for (int u = 0; u < 9; ++u) a9[u] = 0.f;
    const float* wm = p.in[11] + ((size_t)layer * 2048 + kc * 128) * 6144 + col;
    for (int k0 = 0; k0 < 128; k0 += 16) {
      float wv[16];
#pragma unroll
      for (int j = 0; j < 16; ++j) wv[j] = wm[(size_t)(k0 + j) * 6144];
      __builtin_amdgcn_sched_barrier(0);
#pragma unroll
      for (int j = 0; j < 16; ++j)
#pragma unroll
        for (int u = 0; u < 9; ++u) a9[u] += sc[u * 128 + k0 + j] * wv[j];
    }
#pragma unroll
    for (int u = 0; u < 9; ++u) modp[((size_t)(kc * 2 + layer) * 9 + u) * 6144 + col] = a9[u];
  }
  }
  grid.sync();
  XcdBarrier xb = xcd_barrier_post((unsigned*)(p.ws + OFF_XBAR), (volatile LAS unsigned*)&xb_words);
  {
  PHASE_IDS;
  for (size_t idx = gtid; idx < (size_t)2 * 9 * 6144; idx += gthreads) {
    const int col = (int)(idx % 6144), lu_ = (int)(idx / 6144), layer = lu_ / 9;
    float a = p.in[12][(size_t)layer * 6144 + col];
    for (int kc = 0; kc < 16; ++kc) a += modp[(size_t)kc * 2 * 9 * 6144 + idx];
    modb[idx] = a;
  }
  }
  grid.sync();

  unsigned* gcnt = (unsigned*)(ctr + 1000);
  unsigned gtarget = 0u;
  for (int rd = 0; rd < 3; ++rd) {
    for (int layer = 0; layer < 2; ++layer) {
      if (layer == 0) {
      PHASE_IDS;
      for (int row = gwave; row < RR; row += nwaves) {
        const int lu = row >> 12, t = row & 4095, unit = rd * 3 + lu;
        const float4* x4 = (const float4*)x_in_row(p, layer, unit, t);
        const float* md = modb + (size_t)(layer * 9 + unit) * 6144;
        float4 v[8];
        float ss = 0.f;
#pragma unroll
        for (int i = 0; i < 8; ++i) { v[i] = x4[lane + i * 64]; ss += v[i].x * v[i].x + v[i].y * v[i].y + v[i].z * v[i].z + v[i].w * v[i].w; }
        ss = wave_sum(ss);
        const float inv = rsqrtf(ss * (1.f / 2048.f) + 1e-6f);
#pragma unroll
        for (int i = 0; i < 8; ++i) {
          const int col = (lane + i * 64) * 4;
          const float4 g = *(const float4*)(p.in[9] + (size_t)layer * 2048 + col);
          const float4 sh = *(const float4*)(md + col), sc = *(const float4*)(md + 2048 + col);
          const float h0 = v[i].x * inv * g.x * (1.f + sc.x) + sh.x, h1 = v[i].y * inv * g.y * (1.f + sc.y) + sh.y;
          const float h2 = v[i].z * inv * g.z * (1.f + sc.z) + sh.z, h3 = v[i].w * inv * g.w * (1.f + sc.w) + sh.w;
          *(uint2*)(hbuf + (size_t)row * 2048 + col) = uint2{pack2(h0, h1), pack2(h2, h3)};
        }
      }
      xcd_barrier(xb);
      }
      {
        const u16* W = WinT + (size_t)layer * 15360 * 2048;
        const int nfull = (48 * 60 / nb) * nb;
        const int ntl = nfull / nb;
        f32x4 acc[8][4];
#pragma unroll
        for (int a_ = 0; a_ < 8; ++a_)
#pragma unroll
          for (int b_ = 0; b_ < 4; ++b_) acc[a_][b_] = f32x4{0.f, 0.f, 0.f, 0.f};
        if (ntl > 0)
        gemm256_stream<256>(ntl,
          [&](int s_, const u16*& A_, int& lda_, const u16*& B_, int& ldb_, int& nk_) {
            const int t = bid + s_ * nb, mt = t % 48, nt = t / 48;
            A_ = hbuf + (size_t)mt * 256 * 2048; lda_ = 2048; B_ = W + (size_t)nt * 256 * 2048; ldb_ = 2048; nk_ = 32;
          },
          [&](int s_, f32x4 (&ac)[8][4]) {
            const int t = bid + s_ * nb, mt = t % 48, nt = t / 48;
            EPI256(256);
            const bool mg = (nt * 256 >= C_M);
#pragma unroll
            for (int m = 0; m < 8; ++m)
#pragma unroll
              for (int n = 0; n < 4; ++n) {
                f32x4 a = ac[m][n];
                if (mg) { a[0] = sigm(a[0]); a[1] = sigm(a[1]); a[2] = sigm(a[2]); a[3] = sigm(a[3]); }
                *(uint2*)(proj + (size_t)(mt * 256 + E256_ROW(m)) * PS + nt * 256 + E256_COL(n)) = uint2{pack2(a[0], a[1]), pack2(a[2], a[3])};
              }
          }, acc, shm);
        const int nhalf = (48 * 60 - nfull) * 2;
        if (bid < nhalf) {
          f32x4 acc2[4][4];
          ACC_ZERO(acc2);
          const int t = nfull + (bid >> 1), mt = t % 48, nt = t / 48, hf = bid & 1;
          gemm256_stream<128>(1,
            [&](int s_, const u16*& A_, int& lda_, const u16*& B_, int& ldb_, int& nk_) {
              A_ = hbuf + (size_t)mt * 256 * 2048; lda_ = 2048; B_ = W + ((size_t)nt * 256 + hf * 128) * 2048; ldb_ = 2048; nk_ = 32;
            },
            [&](int s_, f32x4 (&ac)[4][4]) {
              EPI256(128);
              const bool mg = (nt * 256 >= C_M);
#pragma unroll
              for (int m = 0; m < 4; ++m)
#pragma unroll
                for (int n = 0; n < 4; ++n) {
                  f32x4 a = ac[m][n];
                  if (mg) { a[0] = sigm(a[0]); a[1] = sigm(a[1]); a[2] = sigm(a[2]); a[3] = sigm(a[3]); }
                  *(uint2*)(proj + (size_t)(mt * 256 + E256_ROW(m)) * PS + nt * 256 + hf * 128 + E256_COL(n)) = uint2{pack2(a[0], a[1]), pack2(a[2], a[3])};
                }
            }, acc2, shm);
        }
      }
      xcd_barrier(xb);
      {
        PHASE_IDS;
        int* cq3 = ctr + 64 + (rd * 2 + layer);
        while (true) {
        const int it = grab(cq3, &s_slot);
        if (it >= 1752) break;
        {
        int layer_o = layer, rd_o = rd;
        asm volatile("" : "+s"(layer_o), "+s"(rd_o));
        const int layer = layer_o, rd = rd_o;
        if (it >= 1368) {
          const int t2 = it - 1368;
          const int t = t2 * 2 + gi;
          const int mt = t % 96, gn = t / 96, g = gn >> 1, nh = gn & 1;
          f32x4 acc[4][4];
          ACC_ZERO(acc);
          gemm_tile(proj + (size_t)mt * 128 * PS + C_UA + g * 128, PS, FWt + ((size_t)(layer * 4 + g) * 256 + nh * 128) * 128, 128, 128, acc, smg);
          EPI_IDX;
#pragma unroll
          for (int mi = 0; mi < 4; ++mi) {
            const int row = mt * 128 + EPI_ROW(mi);
            const int lu = row >> 12, tt = row & 4095, unit = rd * 3 + lu;
            const bool ctx = (unit == 0);
            const int L = ctx ? 256 : 4096;
            const int seq = ctx ? (tt >> 8) : 0, l = ctx ? (tt & 255) : tt;
            u16* base = PQt + (size_t)lu * 4096 * 1024 + (size_t)seq * 512 * 2 * L + (size_t)nh * L + l;
#pragma unroll
            for (int ni = 0; ni < 4; ++ni) {
              const int dcol = EPI_COL(ni);
#pragma unroll
              for (int j = 0; j < 4; ++j) base[(size_t)(g * 128 + dcol + j) * 2 * L] = f2bf(acc[ni][mi][j]);
            }
          }
        }
        if (it < 384) s5_item(p, layer, rd, it, 1, smem);
        else if (it < 1152) hgrnA_item(p, layer, (it - 384) >> 2, (it - 384) & 3, shm);
        const float qscale = 0.08838834764831845f * 1.4426950408889634f;
        if (it >= 1152 && it < 1344)
        for (int rr = 0; rr < 8; ++rr) {
          const int row = (it - 1152) * 64 + wid * 8 + rr;
          const int lu = row >> 12, t = row & 4095, unit = rd * 3 + lu;
          const bool ctx = (unit == 0);
          const int seq = ctx ? (t >> 8) : 0, l = ctx ? (t & 255) : t;
          const u16* pr = proj + (size_t)row * PS;
          const int a = lane >> 5, i = lane & 31;
          float cs = 1.f, sn = 0.f;
          if (!ctx) {
            const float pos = (float)(a == 0 ? (l >> 6) : (l & 63));
            const float ang = pos * __expf(-(float)i * (9.210340371976184f / 32.f));
            cs = __cosf(ang); sn = __sinf(ang);
          }
          u16 rx1[10], rx2[10], rvx[4];
#pragma unroll
          for (int hh = 0; hh < 10; ++hh) {
            const int cb = (hh < 8) ? (C_QC + hh * 128) : (C_KC + (hh - 8) * 128);
            rx1[hh] = pr[cb + a * 64 + i]; rx2[hh] = pr[cb + a * 64 + 32 + i];
          }
#pragma unroll
          for (int e = 0; e < 4; ++e) rvx[e] = pr[C_VC + lane + e * 64];
          __builtin_amdgcn_sched_barrier(0);
#pragma unroll
          for (int hh = 0; hh < 10; ++hh) {
            const float x1 = bf2f(rx1[hh]), x2 = bf2f(rx2[hh]);
            const float ssq = wave_sum(x1 * x1 + x2 * x2);
            const float inv = rsqrtf(ssq * (1.f / 128.f) + 1e-6f);
            const float* gn = (hh < 8) ? (p.in[25] + layer * 128) : (p.in[26] + layer * 128);
            float y1 = x1 * inv * gn[a * 64 + i], y2 = x2 * inv * gn[a * 64 + 32 + i];
            if (hh >= 8 && ctx) {
              const size_t oi = OCK + ((((size_t)seq * 2 + layer) * 256 + l) * 2 + (hh - 8)) * 128 + a * 64 + i;
              p.out[oi] = y1; p.out[oi + 32] = y2;
            }
            const float r1 = y1 * cs - y2 * sn, r2 = y2 * cs + y1 * sn;
            if (hh < 8) {
              Qb[(size_t)row * 1024 + hh * 128 + a * 64 + i] = f2bf(r1 * qscale);
              Qb[(size_t)row * 1024 + hh * 128 + a * 64 + 32 + i] = f2bf(r2 * qscale);
            } else {
              const size_t kr = (size_t)lu * NKMAX + (ctx ? (seq * 256 + l) : l);
              Kb[kr * 256 + (hh - 8) * 128 + a * 64 + i] = f2bf(r1);
              Kb[kr * 256 + (hh - 8) * 128 + a * 64 + 32 + i] = f2bf(r2);
            }
          }
#pragma unroll
          for (int e = 0; e < 4; ++e) {
            const int idx = lane + e * 64, hkv = idx >> 7, dd = idx & 127;
            const u16 vv = rvx[e];
            if (ctx) {
              p.out[OCV + ((((size_t)seq * 2 + layer) * 256 + l) * 2 + hkv) * 128 + dd] = bf2f(vv);
              Vt[(size_t)lu * 256 * NKMAX + ((size_t)(seq * 2 + hkv) * 128 + dd) * 256 + l] = vv;
            } else {
              Vt[(size_t)lu * 256 * NKMAX + ((size_t)hkv * 128 + dd) * NKMAX + l] = vv;
            }
          }
        }
        if (it >= 1344 && it < 1368) {
          float kv[8][4], vvv[8][4];
#pragma unroll
          for (int rr = 0; rr < 8; ++rr) {
            const int r = (it - 1344) * 64 + wid * 8 + rr;
            const int lu = r >> 9, j = r & 511, unit = rd * 3 + lu;
            const size_t ci = (((size_t)((unit > 0 ? unit : 1) - 1) * 2 + layer) * 512 + j) * 256;
#pragma unroll
            for (int e = 0; e < 4; ++e) { kv[rr][e] = p.in[3][ci + lane + e * 64]; vvv[rr][e] = p.in[4][ci + lane + e * 64]; }
          }
          __builtin_amdgcn_sched_barrier(0);
#pragma unroll
          for (int rr = 0; rr < 8; ++rr) {
            const int r = (it - 1344) * 64 + wid * 8 + rr;
            const int lu = r >> 9, j = r & 511, unit = rd * 3 + lu;
            if (unit != 0) {
#pragma unroll
              for (int e = 0; e < 4; ++e) {
                const int idx = lane + e * 64;
                Kb[((size_t)lu * NKMAX + 4096 + j) * 256 + idx] = f2bf(kv[rr][e]);
                Vt[(size_t)lu * 256 * NKMAX + (size_t)idx * NKMAX + 4096 + j] = f2bf(vvv[rr][e]);
              }
            }
          }
        }
        }
        }
      }
      xcd_barrier(xb);
      {
        const int nl = (rd == 0) ? 2 : 3, ncx = (rd == 0) ? 1 : 0, lu0 = ncx;
        const int n_hl = nl * 32, n_at = nl * 128, n_df = 0, n_hc = nl * 8, n_s5 = 384, n_ac = ncx * 128, n_dc = ncx * 32;
        const int e0 = n_hl, e1 = e0 + n_at, e2 = e1 + n_df, e3 = e2 + n_hc, e4 = e3 + n_s5, e5 = e4 + n_ac, e6 = e5 + n_dc;
        const int nb1 = ncx * 1024 + nl * 64;
        int* cq = ctr + (rd * 2 + layer);
        while (true) {
          int it = grab(cq, &s_slot);
          if (it >= e6 + nb1) break;
          if (it < nb1) {
            const int lu = (ncx && it < 1024) ? 0 : (ncx ? 1 + ((it - 1024) >> 6) : (it >> 6));
            const int ii = (ncx && it < 1024) ? it : (ncx ? ((it - 1024) & 63) : (it & 63));
            const int unit = rd * 3 + lu;
            const bool ctx = (unit == 0);
            const int nch = ctx ? 4 : 64;
            u16* dsb = (u16*)(p.ws + OFF_DS);
            const float* dec = (const float*)(p.ws + OFF_DEC);
            const size_t idx = (size_t)ii * 512 + otid();
            {
              const int dq = (int)(idx & 31), e = (int)((idx >> 5) & 127), h = (int)((idx >> 12) & 3), dir = (int)((idx >> 14) & 1), seq = (int)(idx >> 15);
              const int c0 = lu * 64 + seq * nch;
              float S0 = 0.f, S1 = 0.f, S2 = 0.f, S3 = 0.f;
              if (!ctx) {
                const float* st = p.in[7] + (((((size_t)(unit - 1) * 2 + layer) * 2 + dir) * 4 + h) * 128 + dq * 4) * 128 + e;
                S0 = st[0]; S1 = st[128]; S2 = st[256]; S3 = st[384];
              }
              for (int cc = 0; cc < nch; cc += 4) {
                uint2 tv[4]; float4 dc[4]; u16* ptr[4];
#pragma unroll
                for (int k = 0; k < 4; ++k) {
                  const int gc = dir ? (c0 + nch - 1 - cc - k) : (c0 + cc + k);
                  const size_t bi_ = (size_t)(dir * 192 + gc) * 4 + h;
                  ptr[k] = dsb + (bi_ * 128 + e) * 128 + dq * 4;
                  tv[k] = *(const uint2*)ptr[k];
                  dc[k] = *(const float4*)(dec + bi_ * 128 + dq * 4);
                }
#pragma unroll
                for (int k = 0; k < 4; ++k) {
                  *(uint2*)ptr[k] = uint2{pack2(S0, S1), pack2(S2, S3)};
                  S0 = dc[k].x * S0 + bflo(tv[k].x); S1 = dc[k].y * S1 + bfhi(tv[k].x);
                  S2 = dc[k].z * S2 + bflo(tv[k].y); S3 = dc[k].w * S3 + bfhi(tv[k].y);
                }
              }
              if (ctx) {
                float* o = p.out + OHG + (((((size_t)seq * 2 + layer) * 2 + dir) * 4 + h) * 128 + dq * 4) * 128 + e;
                o[0] = S0; o[128] = S1; o[256] = S2; o[384] = S3;
              }
            }
            continue;
          }
          it -= nb1;
          if (it < e0) {
            const int lu = lu0 + it / 32, r = it % 32, mt = r & 7, nt = r >> 3;
            f32x4 acc[4][4], accA[4][4];
            ACC_ZERO(acc);
            ACC_ZERO(accA);
            const u16* Bm = PQt + (size_t)lu * 4096 * 1024 + (size_t)nt * 128 * 8192;
            gemm256_stream<128>(2,
              [&](int s_, const u16*& A_, int& lda_, const u16*& B_, int& ldb_, int& nk_) {
                A_ = DftL + (size_t)mt * 256 * 8192 + s_ * 4096; lda_ = 8192; B_ = Bm + s_ * 4096; ldb_ = 8192; nk_ = 64;
              },
              [&](int s_, f32x4 (&ac)[4][4]) {
                if (s_ == 0) {
#pragma unroll
                  for (int m = 0; m < 4; ++m)
#pragma unroll
                    for (int n = 0; n < 4; ++n) accA[m][n] = ac[m][n];
                } else {
                  EPI256(128);
                  uint2 gs_[4][4];
#pragma unroll
                  for (int m = 0; m < 4; ++m)
#pragma unroll
                    for (int n = 0; n < 4; ++n)
                      gs_[m][n] = *(const uint2*)(proj + ((size_t)lu * 4096 + mt * 256 + E256_ROW(m)) * PS + C_GA + nt * 128 + E256_COL(n));
                  __builtin_amdgcn_sched_barrier(0);
#pragma unroll
                  for (int m = 0; m < 4; ++m)
#pragma unroll
                    for (int n = 0; n < 4; ++n) {
                      const size_t row = (size_t)lu * 4096 + mt * 256 + E256_ROW(m);
                      const int col = nt * 128 + E256_COL(n);
                      const uint2 gg = gs_[m][n];
                      const f32x4 a = accA[m][n] + ac[m][n];
                      *(uint2*)(Z + row * ZS + Z_A + col) = uint2{pack2(a[0] * silu(bflo(gg.x)), a[1] * silu(bfhi(gg.x))),
                                                                   pack2(a[2] * silu(bflo(gg.y)), a[3] * silu(bfhi(gg.y)))};
                    }
                  __builtin_amdgcn_sched_barrier(0);
#pragma unroll
                  for (int m = 0; m < 4; ++m)
#pragma unroll
                    for (int n = 0; n < 4; ++n)
                      gs_[m][n] = *(const uint2*)(proj + ((size_t)lu * 4096 + ((4096 - (mt * 256 + E256_ROW(m))) & 4095)) * PS + C_GA + nt * 128 + E256_COL(n));
                  __builtin_amdgcn_sched_barrier(0);
#pragma unroll
                  for (int m = 0; m < 4; ++m)
#pragma unroll
                    for (int n = 0; n < 4; ++n) {
                      const int k = mt * 256 + E256_ROW(m);
                      const int col = nt * 128 + E256_COL(n);
                      if (k > 0) {
                        const size_t row = (size_t)lu * 4096 + (4096 - k);
                        const uint2 gg = gs_[m][n];
                        const f32x4 a = accA[m][n] - ac[m][n];
                        *(uint2*)(Z + row * ZS + Z_A + col) = uint2{pack2(a[0] * silu(bflo(gg.x)), a[1] * silu(bfhi(gg.x))),
                                                                     pack2(a[2] * silu(bflo(gg.y)), a[3] * silu(bfhi(gg.y)))};
                      }
                    }
                }
              }, acc, shm);
          } else if (it < e1) {
            const int i2 = it - e0, lu = lu0 + i2 / 128, r = i2 % 128;
            attn_item(p, rd * 3 + lu, lu, 0, r >> 4, r & 15, smem);
          } else if (it < e3) {
            const int i2 = it - e2, lu = lu0 + (i2 >> 3), chg = i2 & 7;
            const int tid_ = otid(), lane_ = tid_ & 63, w_ = tid_ >> 6;
            for (int c = 0; c < 8; ++c) {
              const int ch = chg * 64 + w_ * 8 + c;
              const u16* src = PQt + (size_t)lu * 4096 * 1024 + (size_t)ch * 8192 + lane_ * 8;
              uint4 v[8];
#pragma unroll
              for (int i = 0; i < 8; ++i) v[i] = *(const uint4*)(src + i * 512);
              __builtin_amdgcn_sched_barrier(0);
              float a = 0.f;
#pragma unroll
              for (int i = 0; i < 8; ++i)
                a += (bflo(v[i].x) - bfhi(v[i].x)) + (bflo(v[i].y) - bfhi(v[i].y)) + (bflo(v[i].z) - bfhi(v[i].z)) + (bflo(v[i].w) - bfhi(v[i].w));
              a = wave_sum(a) * (1.f / 64.f);
              if (lane_ == 0) {
                const size_t row = (size_t)lu * 4096 + 2048;
                Z[row * ZS + Z_A + ch] = f2bf(a * silu(bf2f(proj[row * PS + C_GA + ch])));
              }
            }
          } else if (it < e4) {
            s5_item(p, layer, rd, it - e3, 2, smem);
          } else if (it < e5) {
            const int i2 = it - e4, seq = i2 >> 3, r = i2 & 7;
            attn_item(p, 0, 0, seq, r, 0, smem);
          } else {
            const int i2 = it - e5;
            for (int q = 0; q < 2; ++q) {
              const int tix = i2 * 4 + q * 2 + (int)(otid() >> 8), seq = tix >> 3, r = tix & 7, mt = r & 1, nt = r >> 1;
              f32x4 acc[4][4];
              ACC_ZERO(acc);
              gemm_tile(DftS + (size_t)mt * 128 * 512, 512, PQt + (size_t)seq * 512 * 512 + (size_t)nt * 128 * 512, 512, 512, acc, smem + (otid() >> 8) * 20480);
              EPI_IDX;
#pragma unroll
              for (int ni = 0; ni < 4; ++ni)
#pragma unroll
                for (int mi = 0; mi < 4; ++mi) {
                  const size_t row = (size_t)seq * 256 + mt * 128 + EPI_ROW(mi);
                  const int col = nt * 128 + EPI_COL(ni);
                  const uint2 gg = *(const uint2*)(proj + row * PS + C_GA + col);
                  const f32x4 a = acc[ni][mi];
                  *(uint2*)(Z + row * ZS + Z_A + col) = uint2{pack2(a[0] * silu(bflo(gg.x)), a[1] * silu(bfhi(gg.x))),
                                                               pack2(a[2] * silu(bflo(gg.y)), a[3] * silu(bfhi(gg.y)))};
                }
            }
          }
        }
      }
      xcd_barrier(xb);
      {
      PHASE_IDS;
      for (int row = gwave; row < RR; row += nwaves) {
        const u16* pr = proj + (size_t)row * PS;
        {
          const int c0 = lane * 8;
          const uint4 ya_ = *(const uint4*)(ys + (size_t)row * 512 + c0), yb_ = *(const uint4*)(ys + (size_t)(RR + row) * 512 + c0);
          const float4 a0 = float4{bflo(ya_.x), bfhi(ya_.x), bflo(ya_.y), bfhi(ya_.y)}, a1 = float4{bflo(ya_.z), bfhi(ya_.z), bflo(ya_.w), bfhi(ya_.w)};
          const float4 b0 = float4{bflo(yb_.x), bfhi(yb_.x), bflo(yb_.y), bfhi(yb_.y)}, b1 = float4{bflo(yb_.z), bfhi(yb_.z), bflo(yb_.w), bfhi(yb_.w)};
          const float4 d0 = *(const float4*)(p.in[22] + (size_t)layer * 512 + c0), d1 = *(const float4*)(p.in[22] + (size_t)layer * 512 + c0 + 4);
          const uint4 uu = *(const uint4*)(pr + C_UB + c0);
          uint4 o;
          o.x = pack2(gelu_t(a0.x + b0.x + d0.x * bflo(uu.x)), gelu_t(a0.y + b0.y + d0.y * bfhi(uu.x)));
          o.y = pack2(gelu_t(a0.z + b0.z + d0.z * bflo(uu.y)), gelu_t(a0.w + b0.w + d0.w * bfhi(uu.y)));
          o.z = pack2(gelu_t(a1.x + b1.x + d1.x * bflo(uu.z)), gelu_t(a1.y + b1.y + d1.y * bfhi(uu.z)));
          o.w = pack2(gelu_t(a1.z + b1.z + d1.z * bflo(uu.w)), gelu_t(a1.w + b1.w + d1.w * bfhi(uu.w)));
          *(uint4*)(yb + (size_t)row * 512 + c0) = o;
        }
      }
      for (int it = bid; it < 384; it += nb) hgrnB2_item(p, layer, it >> 1, it & 1);
      }
      xcd_barrier(xb);
      for (int t2 = bid; t2 < 96 * 2; t2 += nb) {
        const int gi6 = (int)(otid() >> 8);
        const int t = t2 * 2 + gi6;
        const int mt = t % 96, nt = t / 96;
        f32x4 acc[4][4];
        ACC_ZERO(acc);
        gemm_tile(yb + (size_t)mt * 128 * 512, 512, GluT + (size_t)layer * 512 * 512 + (size_t)nt * 128 * 512, 512, 512, acc, smem + gi6 * 20480);
        EPI_IDX;
        float4 bbs[4]; uint2 yys[4][4], ggs[4][4];
#pragma unroll
        for (int ni = 0; ni < 4; ++ni) {
          bbs[ni] = *(const float4*)(p.in[24] + (size_t)layer * 512 + nt * 128 + EPI_COL(ni));
#pragma unroll
          for (int mi = 0; mi < 4; ++mi) {
            const size_t row = (size_t)mt * 128 + EPI_ROW(mi);
            const int col = nt * 128 + EPI_COL(ni);
            yys[ni][mi] = *(const uint2*)(yb + row * 512 + col);
            ggs[ni][mi] = *(const uint2*)(proj + row * PS + C_GB + col);
          }
        }
        __builtin_amdgcn_sched_barrier(0);
#pragma unroll
        for (int ni = 0; ni < 4; ++ni)
#pragma unroll
          for (int mi = 0; mi < 4; ++mi) {
            const size_t row = (size_t)mt * 128 + EPI_ROW(mi);
            const int col = nt * 128 + EPI_COL(ni);
            const float4 bb = bbs[ni];
            const uint2 yy = yys[ni][mi];
            const uint2 gg = ggs[ni][mi];
            const f32x4 a = acc[ni][mi];
            const float r0 = bflo(yy.x) * sigm(a[0] + bb.x) * silu(bflo(gg.x)), r1 = bfhi(yy.x) * sigm(a[1] + bb.y) * silu(bfhi(gg.x));
            const float r2 = bflo(yy.y) * sigm(a[2] + bb.z) * silu(bflo(gg.y)), r3 = bfhi(yy.y) * sigm(a[3] + bb.w) * silu(bfhi(gg.y));
            *(uint2*)(Z + row * ZS + Z_B + col) = uint2{pack2(r0, r1), pack2(r2, r3)};
          }
      }
      xcd_barrier(xb);
      {
        const int ntl = (48 * 16 - bid + nb - 1) / nb;
        f32x4 mix[4][4], acc[4][4];
        ACC_ZERO(mix);
        ACC_ZERO(acc);
        if (ntl > 0)
        gemm256_stream<128>(ntl * 4,
          [&](int s_, const u16*& A_, int& lda_, const u16*& B_, int& ldb_, int& nk_) {
            const int t = bid + (s_ >> 2) * nb, mt = t % 48, nt = t / 48, j = s_ & 3;
            const int Kj = (j == 2) ? 1024 : 512;
            const int zo = (j == 0) ? Z_A : (j == 1) ? Z_B : (j == 2) ? Z_C : Z_D;
            const u16* Wj = (j == 0) ? WpA : (j == 1) ? WpB : (j == 2) ? WpC : WpD;
            A_ = Z + (size_t)mt * 256 * ZS + zo; lda_ = ZS; B_ = Wj + (size_t)layer * 2048 * Kj + (size_t)nt * 128 * Kj; ldb_ = Kj; nk_ = Kj >> 6;
          },
          [&](int s_, f32x4 (&ac)[4][4]) {
            const int t = bid + (s_ >> 2) * nb, mt = t % 48, nt = t / 48, j = s_ & 3;
            EPI256(128);
            uint2 ggs[4][4];
#pragma unroll
            for (int m = 0; m < 4; ++m)
#pragma unroll
              for (int n = 0; n < 4; ++n)
                ggs[m][n] = *(const uint2*)(proj + ((size_t)mt * 256 + E256_ROW(m)) * PS + C_M + j * 2048 + nt * 128 + E256_COL(n));
            __builtin_amdgcn_sched_barrier(0);
#pragma unroll
            for (int m = 0; m < 4; ++m)
#pragma unroll
              for (int n = 0; n < 4; ++n) {
                const size_t row = (size_t)mt * 256 + E256_ROW(m);
                const int col = nt * 128 + E256_COL(n);
                const uint2 gg = ggs[m][n];
                mix[m][n][0] += bflo(gg.x) * ac[m][n][0];
                mix[m][n][1] += bfhi(gg.x) * ac[m][n][1];
                mix[m][n][2] += bflo(gg.y) * ac[m][n][2];
                mix[m][n][3] += bfhi(gg.y) * ac[m][n][3];
                if (j == 3) {
                  *(uint2*)(mixed + row * 2048 + col) = uint2{pack2(mix[m][n][0], mix[m][n][1]), pack2(mix[m][n][2], mix[m][n][3])};
                  mix[m][n] = f32x4{0.f, 0.f, 0.f, 0.f};
                }
              }
          }, acc, shm);
      }
      xcd_barrier(xb);
      {
        const int ntl = (48 * 16 - bid + nb - 1) / nb;
        f32x4 acc[4][4];
        ACC_ZERO(acc);
        if (ntl > 0)
        gemm256_stream<128>(ntl,
          [&](int s_, const u16*& A_, int& lda_, const u16*& B_, int& ldb_, int& nk_) {
            const int t = bid + s_ * nb, mt = t % 48, nt = t / 48;
            A_ = mixed + (size_t)mt * 256 * 2048; lda_ = 2048; B_ = WoutT + (size_t)layer * 2048 * 2048 + (size_t)nt * 128 * 2048; ldb_ = 2048; nk_ = 32;
          },
          [&](int s_, f32x4 (&ac)[4][4]) {
            const int t = bid + s_ * nb, mt = t % 48, nt = t / 48;
            EPI256(128);
#pragma unroll
            for (int m = 0; m < 4; ++m)
#pragma unroll
              for (int n = 0; n < 4; ++n) {
                const size_t row = (size_t)mt * 256 + E256_ROW(m);
                const int col = nt * 128 + E256_COL(n);
                *(uint2*)(outb + row * 2048 + col) = uint2{pack2(ac[m][n][0], ac[m][n][1]), pack2(ac[m][n][2], ac[m][n][3])};
              }
          }, acc, shm);
      }
      xcd_barrier(xb);
      {
      PHASE_IDS;
      for (int row = gwave; row < RR; row += nwaves) {
        const int lu = row >> 12, t = row & 4095, unit = rd * 3 + lu;
        const float4* x4 = (const float4*)x_in_row(p, layer, unit, t);
        float4* y4 = (float4*)y_out_row(p, unit, t);
        const float* md = modb + (size_t)(layer * 9 + unit) * 6144 + 4096;
        const uint2* o4 = (const uint2*)(outb + (size_t)row * 2048);
        float4 v[8];
        float ss = 0.f;
#pragma unroll
        for (int i = 0; i < 8; ++i) {
          const uint2 ov = o4[lane + i * 64];
          v[i] = float4{bflo(ov.x), bfhi(ov.x), bflo(ov.y), bfhi(ov.y)};
          ss += v[i].x * v[i].x + v[i].y * v[i].y + v[i].z * v[i].z + v[i].w * v[i].w;
        }
        ss = wave_sum(ss);
        const float inv = rsqrtf(ss * (1.f / 2048.f) + 1e-6f);
        float4 xvs[8];
#pragma unroll
        for (int i = 0; i < 8; ++i) xvs[i] = x4[lane + i * 64];
        __builtin_amdgcn_sched_barrier(0);
#pragma unroll
        for (int i = 0; i < 8; ++i) {
          const int col = (lane + i * 64) * 4;
          const float4 g = *(const float4*)(p.in[10] + (size_t)layer * 2048 + col);
          const float4 gt = *(const float4*)(md + col);
          const float4 xv = xvs[i];
          float4 y;
          y.x = xv.x + gt.x * (v[i].x * inv * g.x); y.y = xv.y + gt.y * (v[i].y * inv * g.y);
          y.z = xv.z + gt.z * (v[i].z * inv * g.z); y.w = xv.w + gt.w * (v[i].w * inv * g.w);
          y4[lane + i * 64] = y;
          v[i] = y;
        }
        if (layer == 0) {
          float s2 = 0.f;
#pragma unroll
          for (int i = 0; i < 8; ++i) s2 += v[i].x * v[i].x + v[i].y * v[i].y + v[i].z * v[i].z + v[i].w * v[i].w;
          s2 = wave_sum(s2);
          const float inv2 = rsqrtf(s2 * (1.f / 2048.f) + 1e-6f);
          const float* md1 = modb + (size_t)(9 + unit) * 6144;
#pragma unroll
          for (int i = 0; i < 8; ++i) {
            const int col = (lane + i * 64) * 4;
            const float4 g = *(const float4*)(p.in[9] + 2048 + col);
            const float4 sh = *(const float4*)(md1 + col), sc = *(const float4*)(md1 + 2048 + col);
            const float h0 = v[i].x * inv2 * g.x * (1.f + sc.x) + sh.x, h1 = v[i].y * inv2 * g.y * (1.f + sc.y) + sh.y;
            const float h2 = v[i].z * inv2 * g.z * (1.f + sc.z) + sh.z, h3 = v[i].w * inv2 * g.w * (1.f + sc.w) + sh.w;
            *(uint2*)(hbuf + (size_t)row * 2048 + col) = uint2{pack2(h0, h1), pack2(h2, h3)};
          }
        }
      }
      }
      xcd_barrier(xb);
    }
  }
}

extern "C" void kernel_launch(void* const* d_in, const int* in_sizes, int n_in,
                              void* d_out, int out_size, void* d_ws, size_t ws_size,
                              hipStream_t stream) {
  static int grid_blocks = 0;
  if (!grid_blocks) {
    int dev = 0, cus = 0, per_cu = 0;
    (void)hipGetDevice(&dev);
    (void)hipDeviceGetAttribute(&cus, hipDeviceAttributeMultiprocessorCount, dev);
    (void)hipOccupancyMaxActiveBlocksPerMultiprocessor(&per_cu, mega, 512, 0);
    if (per_cu > 1) per_cu = 1;
    if (per_cu < 1) per_cu = 1;
    grid_blocks = cus * per_cu;
  }
  if (ws_size < OFF_END) { fprintf(stderr, "workspace too small: %zu < %zu\n", ws_size, (size_t)OFF_END); return; }
  Params p{};
  for (int i = 0; i < 34; ++i) p.in[i] = (const float*)d_in[i];
  p.out = (float*)d_out;
  p.ws = (char*)d_ws;
  void* args[] = {&p};
  hipError_t e = hipLaunchCooperativeKernel((void*)mega, dim3(grid_blocks), dim3(512), args, 0, stream);
  if (e != hipSuccess) fprintf(stderr, "cooperative launch failed: %s (grid %d)\n", hipGetErrorString(e), grid_blocks);
}
```

```cpp
#include <hip/hip_runtime.h>
#include <hip/hip_cooperative_groups.h>
#include <cstdio>
namespace cg = cooperative_groups;

typedef unsigned short u16;
using bf16x8 = __attribute__((ext_vector_type(8))) short;
using f32x4 = __attribute__((ext_vector_type(4))) float;
using u32x4 = __attribute__((ext_vector_type(4))) unsigned;

struct Params { const float* in[34]; float* out; char* ws; };

constexpr int DM = 2048;
constexpr int PS = 15360;
constexpr int C_UA = 0, C_GA = 512, C_UB = 1024, C_GB = 1536, C_QC = 2048, C_KC = 3072, C_VC = 3328, C_GC = 3584,
              C_QD = 4608, C_ID = 5120, C_ZF = 5632, C_ZB = 6144, C_GD = 6656, C_M = 7168;
constexpr int ZS = 2560;
constexpr int Z_A = 0, Z_B = 512, Z_C = 1024, Z_D = 2048;
constexpr int RR = 12288;
constexpr int NKMAX = 4608;

constexpr size_t OY_S = 8388608, OCK = 75497472, OCV = 77594624, OS5R = 79691776, OS5I = 79822848, OHG = 79953920;

constexpr size_t OFF_WINT = 0;
constexpr size_t OFF_WPA = OFF_WINT + (size_t)2 * 15360 * 2048 * 2;
constexpr size_t OFF_WPB = OFF_WPA + (size_t)2 * 2048 * 512 * 2;
constexpr size_t OFF_WPC = OFF_WPB + (size_t)2 * 2048 * 512 * 2;
constexpr size_t OFF_WPD = OFF_WPC + (size_t)2 * 2048 * 1024 * 2;
constexpr size_t OFF_WOUT = OFF_WPD + (size_t)2 * 2048 * 512 * 2;
constexpr size_t OFF_GLU = OFF_WOUT + (size_t)2 * 2048 * 2048 * 2;
constexpr size_t OFF_FWT = OFF_GLU + (size_t)2 * 512 * 512 * 2;
constexpr size_t OFF_DFTL = OFF_FWT + (size_t)2 * 4 * 256 * 128 * 2;
constexpr size_t OFF_DFTS = OFF_DFTL + (size_t)4096 * 8192 * 2;
constexpr size_t OFF_MODP = OFF_DFTS + (size_t)256 * 512 * 2;
constexpr size_t OFF_MOD = OFF_MODP + (size_t)16 * 2 * 9 * 6144 * 4;
constexpr size_t OFF_CTR = OFF_MOD + (size_t)2 * 9 * 6144 * 4;
constexpr size_t OFF_H = OFF_CTR + 4096;
constexpr size_t OFF_PROJ = OFF_H + (size_t)RR * 2048 * 2;
constexpr size_t OFF_Z = OFF_PROJ + (size_t)RR * PS * 2;
constexpr size_t OFF_PQT = OFF_Z + (size_t)RR * ZS * 2;
constexpr size_t OFF_YS = OFF_PQT + (size_t)RR * 1024 * 2;
constexpr size_t OFF_YB = OFF_YS + (size_t)2 * RR * 512 * 4;
constexpr size_t OFF_QB = OFF_YB + (size_t)RR * 512 * 2;
constexpr size_t OFF_KB = OFF_QB + (size_t)RR * 1024 * 2;
constexpr size_t OFF_VT = OFF_KB + (size_t)3 * NKMAX * 256 * 2;
constexpr size_t OFF_OHG = OFF_VT + (size_t)3 * 256 * NKMAX * 2;
constexpr size_t OFF_S5LOC = OFF_OHG + (size_t)2 * RR * 512 * 4;
constexpr size_t OFF_MIXED = OFF_S5LOC + (size_t)3072 * 128 * 4;
constexpr size_t OFF_QIB = OFF_MIXED + (size_t)RR * 2048 * 2;
constexpr size_t OFF_DS = OFF_QIB + (size_t)2 * RR * 512 * 2;
constexpr size_t OFF_DEC = OFF_DS + (size_t)2 * 192 * 4 * 128 * 128 * 2;
constexpr size_t OFF_XBAR = OFF_DEC + (size_t)2 * 192 * 4 * 128 * 4;
constexpr size_t OFF_END = OFF_XBAR + 16384;
constexpr size_t OFF_OUTB = OFF_PROJ;

__device__ __forceinline__ float bf2f(u16 h) { return __uint_as_float(((unsigned)h) << 16); }
__device__ __forceinline__ float bflo(unsigned w) { return __uint_as_float(w << 16); }
__device__ __forceinline__ float bfhi(unsigned w) { return __uint_as_float(w & 0xffff0000u); }
typedef float f32x2_t __attribute__((ext_vector_type(2)));
typedef __bf16 bf16x2_t __attribute__((ext_vector_type(2)));
__device__ __forceinline__ unsigned pack2(float a, float b) {
  f32x2_t v = {a, b};
  bf16x2_t r = __builtin_convertvector(v, bf16x2_t);
  return __builtin_bit_cast(unsigned, r);
}
__device__ __forceinline__ u16 f2bf(float f) { return (u16)(pack2(f, f) & 0xffffu); }
__device__ __forceinline__ float sigm(float x) { return __builtin_amdgcn_rcpf(1.f + __expf(-x)); }
__device__ __forceinline__ float silu(float x) { return x * __builtin_amdgcn_rcpf(1.f + __expf(-x)); }
__device__ __forceinline__ float gelu_t(float x) {
  float u = 0.7978845608028654f * (x + 0.044715f * x * x * x);
  float t = 1.f - 2.f * __builtin_amdgcn_rcpf(1.f + __expf(2.f * u));
  return 0.5f * x * (1.f + t);
}
__device__ __forceinline__ float rowmax4(float x) {
  auto r = __builtin_amdgcn_permlane16_swap(__float_as_uint(x), __float_as_uint(x), false, false);
  const float m = fmaxf(__uint_as_float(r[0]), __uint_as_float(r[1]));
  auto q = __builtin_amdgcn_permlane32_swap(__float_as_uint(m), __float_as_uint(m), false, false);
  return fmaxf(__uint_as_float(q[0]), __uint_as_float(q[1]));
}
__device__ __forceinline__ float rowsum4(float x) {
  auto r = __builtin_amdgcn_permlane16_swap(__float_as_uint(x), __float_as_uint(x), false, false);
  const float m = __uint_as_float(r[0]) + __uint_as_float(r[1]);
  auto q = __builtin_amdgcn_permlane32_swap(__float_as_uint(m), __float_as_uint(m), false, false);
  return __uint_as_float(q[0]) + __uint_as_float(q[1]);
}
__device__ __forceinline__ float wave_sum(float v) {
  v = rowsum4(v);
#pragma unroll
  for (int o = 8; o > 0; o >>= 1) v += __shfl_xor(v, o);
  return v;
}
__device__ __forceinline__ int grab(int* ctr, int* slot) {
  __syncthreads();
  if (threadIdx.x == 0) *slot = atomicAdd(ctr, 1);
  __syncthreads();
  return *slot;
}

__device__ __forceinline__ int otid() { int t = threadIdx.x; asm volatile("" : "+v"(t)); return t; }
#define XB_TMO      128
#define XB_XCNT(j)  (256  + 64 * (j))
#define XB_XSUB(j)  (1280 + 64 * (j))
#define XB_XGEN(j)  (2304 + 64 * (j))
#define XB_TOP      3328
#define XB_TOPGEN   3392
#define XCD_BAR_WORDS 3456
#define XB_SPIN_CAP (1u << 18)
#define LAS __attribute__((address_space(3)))

__device__ __forceinline__ unsigned xb_ld(unsigned* p)              { return __hip_atomic_load(p, __ATOMIC_RELAXED, __HIP_MEMORY_SCOPE_AGENT); }
__device__ __forceinline__ unsigned xb_add(unsigned* p, unsigned v) { return __hip_atomic_fetch_add(p, v, __ATOMIC_RELAXED, __HIP_MEMORY_SCOPE_AGENT); }
__device__ __forceinline__ unsigned xb_xcc_id() { return (unsigned)__builtin_amdgcn_s_getreg((3 << 11) | 20) & 0xFu; }
#define XB_SPIN(cond, bar) do { unsigned _sp = 0; while (cond) { __builtin_amdgcn_s_sleep(1); \
    if ((++_sp & 255u) == 0u) { if (xb_ld(&(bar)[XB_TMO])) break; if (_sp > XB_SPIN_CAP) { atomicAdd(&(bar)[XB_TMO], 1u); break; } } } } while (0)

struct XcdBarrier {
    unsigned* bar; unsigned x;
    volatile LAS unsigned* st;
};

__device__ __forceinline__ XcdBarrier xcd_barrier_post(unsigned* bar, volatile LAS unsigned* st) {
    XcdBarrier b; b.bar = bar; b.x = xb_xcc_id(); b.st = st;
    if (threadIdx.x == 0) (void)xb_add(&bar[XB_XCNT(b.x)], 1u);
    return b;
}
__device__ __forceinline__ void xcd_barrier_complete(unsigned* bar, unsigned x, unsigned& nloc, unsigned& nx) {
    const unsigned G = gridDim.x * gridDim.y * gridDim.z;
    unsigned sum, cnt, mine, sp = 0u;
    for (;;) {
        sum = 0u; cnt = 0u; mine = 0u;
#pragma unroll
        for (unsigned j = 0; j < 16; ++j) { const unsigned c = xb_ld(&bar[XB_XCNT(j)]); sum += c; cnt += (c > 0u) ? 1u : 0u; mine = (j == x) ? c : mine; }
        if (sum == G) break;
        __builtin_amdgcn_s_sleep(1);
        if ((++sp & 255u) == 0u) { if (xb_ld(&bar[XB_TMO])) break; if (sp > XB_SPIN_CAP) { atomicAdd(&bar[XB_TMO], 1u); break; } }
    }
    nloc = mine > 0u ? mine : 1u; nx = cnt > 0u ? cnt : 1u;
}

__device__ __forceinline__ void xcd_barrier(const XcdBarrier& b) {
    asm volatile("s_waitcnt vmcnt(0)" ::: "memory");
    __syncthreads();
    if (threadIdx.x == 0) {
        unsigned* bar = b.bar;
        __builtin_amdgcn_s_waitcnt(0);
        unsigned nloc = b.st[0], nx = b.st[1];
        if (nloc == 0u) { xcd_barrier_complete(bar, b.x, nloc, nx); b.st[0] = nloc; b.st[1] = nx; }
        const unsigned old = xb_add(&bar[XB_XSUB(b.x)], 1u);
        const unsigned gen = old / nloc;
        if (old + 1u == (gen + 1u) * nloc) {
            __builtin_amdgcn_fence(__ATOMIC_RELEASE, "agent");
            asm volatile("s_waitcnt vmcnt(0)" ::: "memory");
            const unsigned og = xb_add(&bar[XB_TOP], 1u);
            const unsigned tg = og / nx;
            if (og + 1u == (tg + 1u) * nx) xb_add(&bar[XB_TOPGEN], 1u);
            else XB_SPIN(xb_ld(&bar[XB_TOPGEN]) == tg, bar);
            __builtin_amdgcn_fence(__ATOMIC_ACQUIRE, "agent");
            xb_add(&bar[XB_XGEN(b.x)], 1u);
            asm volatile("s_waitcnt vmcnt(0)" ::: "memory");
        } else {
            XB_SPIN(xb_ld(&bar[XB_XGEN(b.x)]) == gen, bar);
            __builtin_amdgcn_fence(__ATOMIC_ACQUIRE, "agent");
            asm volatile("s_waitcnt vmcnt(0)" ::: "memory");
        }
    }
    __syncthreads();
}

__device__ __forceinline__ void gbar(unsigned* cnt, unsigned& target) {
  asm volatile("s_waitcnt vmcnt(0)" ::: "memory");
  __syncthreads();
  target += gridDim.x;
  if (threadIdx.x == 0) {
    __builtin_amdgcn_fence(__ATOMIC_RELEASE, "agent");
    asm volatile("s_waitcnt vmcnt(0)" ::: "memory");
    __hip_atomic_fetch_add(cnt, 1u, __ATOMIC_RELAXED, __HIP_MEMORY_SCOPE_AGENT);
    while (__hip_atomic_load(cnt, __ATOMIC_RELAXED, __HIP_MEMORY_SCOPE_AGENT) < target) __builtin_amdgcn_s_sleep(1);
    __builtin_amdgcn_fence(__ATOMIC_ACQUIRE, "agent");
    asm volatile("s_waitcnt vmcnt(0)" ::: "memory");
  }
  __syncthreads();
}
__device__ __forceinline__ const float* x_in_row(const Params& p, int layer, int unit, int t) {
  size_t off = (unit == 0) ? (size_t)t * DM : (size_t)((unit - 1) * 4096 + t) * DM;
  if (layer == 0) return ((unit == 0) ? p.in[0] : p.in[1]) + off;
  return p.out + ((unit == 0) ? 0 : OY_S) + off;
}
__device__ __forceinline__ float* y_out_row(const Params& p, int unit, int t) {
  size_t off = (unit == 0) ? (size_t)t * DM : (size_t)((unit - 1) * 4096 + t) * DM;
  return p.out + ((unit == 0) ? 0 : OY_S) + off;
}

constexpr int LDT = 40;
__device__ __forceinline__ void gemm_tile(const u16* __restrict__ A, size_t lda, const u16* __restrict__ B, size_t ldb,
                                          int K, f32x4 (&acc)[4][4], u16* sm) {
  const int tid = otid() & 255, lane = tid & 63, wid = tid >> 6, wr = wid >> 1, wc = wid & 1, fr = lane & 15, fq = lane >> 4;
  u16* As = sm;
  u16* Bs = sm + 2 * 128 * LDT;
  const int lrow = tid >> 2, lkc = (tid & 3) * 8;
  const u16* Ag = A + (size_t)lrow * lda + lkc;
  const u16* Bg = B + (size_t)lrow * ldb + lkc;
  const size_t a64 = 64 * lda, b64 = 64 * ldb;
  uint4 ra0 = *(const uint4*)(Ag), ra1 = *(const uint4*)(Ag + a64);
  uint4 rb0 = *(const uint4*)(Bg), rb1 = *(const uint4*)(Bg + b64);
  __syncthreads();
  *(uint4*)(As + lrow * LDT + lkc) = ra0;
  *(uint4*)(As + (lrow + 64) * LDT + lkc) = ra1;
  *(uint4*)(Bs + lrow * LDT + lkc) = rb0;
  *(uint4*)(Bs + (lrow + 64) * LDT + lkc) = rb1;
  __syncthreads();
  const int nk = K >> 5;
  for (int kt = 0; kt < nk; ++kt) {
    const int cur = kt & 1;
    const bool more = (kt + 1 < nk);
    if (more) {
      const int ko = (kt + 1) * 32;
      ra0 = *(const uint4*)(Ag + ko); ra1 = *(const uint4*)(Ag + a64 + ko);
      rb0 = *(const uint4*)(Bg + ko); rb1 = *(const uint4*)(Bg + b64 + ko);
    }
    const u16* as = As + cur * 128 * LDT;
    const u16* bs = Bs + cur * 128 * LDT;
    bf16x8 af[4], bfg[4];
#pragma unroll
    for (int i = 0; i < 4; ++i) {
      af[i] = *(const bf16x8*)(as + (wr * 64 + i * 16 + fr) * LDT + fq * 8);
      bfg[i] = *(const bf16x8*)(bs + (wc * 64 + i * 16 + fr) * LDT + fq * 8);
    }
#pragma unroll
    for (int ni = 0; ni < 4; ++ni)
#pragma unroll
      for (int mi = 0; mi < 4; ++mi)
        acc[ni][mi] = __builtin_amdgcn_mfma_f32_16x16x32_bf16(bfg[ni], af[mi], acc[ni][mi], 0, 0, 0);
    if (more) {
      u16* aw = As + (cur ^ 1) * 128 * LDT;
      u16* bw = Bs + (cur ^ 1) * 128 * LDT;
      *(uint4*)(aw + lrow * LDT + lkc) = ra0;
      *(uint4*)(aw + (lrow + 64) * LDT + lkc) = ra1;
      *(uint4*)(bw + lrow * LDT + lkc) = rb0;
      *(uint4*)(bw + (lrow + 64) * LDT + lkc) = rb1;
    }
    __syncthreads();
  }
}
#define ACC_ZERO(acc) _Pragma("unroll") for (int _a = 0; _a < 4; ++_a) _Pragma("unroll") for (int _b = 0; _b < 4; ++_b) acc[_a][_b] = f32x4{0.f, 0.f, 0.f, 0.f}
#define EPI_IDX const int tid_ = otid() & 255, lane_ = tid_ & 63, wid_ = tid_ >> 6, wr_ = wid_ >> 1, wc_ = wid_ & 1, fr_ = lane_ & 15, fq_ = lane_ >> 4
#define EPI_ROW(mi) (wr_ * 64 + (mi) * 16 + fr_)
#define EPI_COL(ni) (wc_ * 64 + (ni) * 16 + fq_ * 4)


__device__ __forceinline__ int lds_byte2(int r, int c) {
  int st = (r >> 4) * 2 + (c >> 5), ob = (r & 15) * 64 + (c & 31) * 2;
  return st * 1024 + (ob ^ (((ob >> 9) & 1) << 5));
}
__device__ __forceinline__ void stage_rc2(int b, int& R, int& C) {
  int st = b >> 10, sb = b & 1023, swz = sb ^ (((sb >> 9) & 1) << 5);
  R = (st >> 1) * 16 + swz / 64;
  C = (st & 1) * 32 + (swz % 64) / 2;
}
using i32x4 = __attribute__((ext_vector_type(4))) int;
template <int BN>
__device__ __forceinline__ void gemm256(const u16* __restrict__ A, int lda, const u16* __restrict__ B, int ldb, int K,
                                        f32x4 (&acc)[(BN == 256) ? 8 : 4][4], char* shm) {
  constexpr int MT = (BN == 256) ? 8 : 4, WM = MT * 16;
  constexpr int TA = 256 * 64 * 2, TB = BN * 64 * 2, STAGE = TA + TB;
  constexpr int GLA = 4, GLB = TB / 8192;
  const int tid = otid(), wid = tid >> 6, lane = tid & 63, fr = lane & 15, fq = lane >> 4;
  const int wr = (BN == 256) ? (wid >> 2) : (wid >> 1), wc = (BN == 256) ? (wid & 3) : (wid & 1);
  int oa[GLA], ob[GLB];
#pragma unroll
  for (int i = 0; i < GLA; ++i) { int R, C; stage_rc2(wid * 1024 + i * 8192 + lane * 16, R, C); oa[i] = R * lda + C; }
#pragma unroll
  for (int i = 0; i < GLB; ++i) { int R, C; stage_rc2(wid * 1024 + i * 8192 + lane * 16, R, C); ob[i] = R * ldb + C; }
  i32x4 sa[GLA], sb[GLB];
  char* wbase = shm + wid * 1024 + lane * 16;
#define G_ISSUE(kt) do { _Pragma("unroll") for (int i = 0; i < GLA; ++i) sa[i] = *(const i32x4*)(A + oa[i] + (kt) * 64); \
                         _Pragma("unroll") for (int i = 0; i < GLB; ++i) sb[i] = *(const i32x4*)(B + ob[i] + (kt) * 64); } while (0)
#define G_WRITE(buf) do { _Pragma("unroll") for (int i = 0; i < GLA; ++i) *(i32x4*)(wbase + (buf) * STAGE + i * 8192) = sa[i]; \
                          _Pragma("unroll") for (int i = 0; i < GLB; ++i) *(i32x4*)(wbase + (buf) * STAGE + TA + i * 8192) = sb[i]; } while (0)
  const int nt = K >> 6;
  G_ISSUE(0);
  __syncthreads();
  G_WRITE(0);
  G_ISSUE(1);
  __syncthreads();
  for (int t = 0; t < nt; ++t) {
    const int cur = t & 1;
    if (t + 1 < nt) G_WRITE(cur ^ 1);
    if (t + 2 < nt) G_ISSUE(t + 2);
    const char* sA = shm + cur * STAGE;
    const char* sB = sA + TA;
#pragma unroll
    for (int ks = 0; ks < 2; ++ks) {
      bf16x8 At[MT], Bf[4];
#pragma unroll
      for (int m = 0; m < MT; ++m) At[m] = *(const bf16x8*)(sA + lds_byte2(wr * WM + m * 16 + fr, ks * 32 + fq * 8));
#pragma unroll
      for (int n = 0; n < 4; ++n) Bf[n] = *(const bf16x8*)(sB + lds_byte2(wc * 64 + n * 16 + fr, ks * 32 + fq * 8));
#pragma unroll
      for (int m = 0; m < MT; ++m)
#pragma unroll
        for (int n = 0; n < 4; ++n) acc[m][n] = __builtin_amdgcn_mfma_f32_16x16x32_bf16(Bf[n], At[m], acc[m][n], 0, 0, 0);
    }
    __syncthreads();
  }
#undef G_ISSUE
#undef G_WRITE
}

template <int BN, class SegFn, class EndFn>
__device__ __forceinline__ void gemm256_stream(int nseg, SegFn seg, EndFn endf, f32x4 (&acc)[(BN == 256) ? 8 : 4][4], char* shm) {
  constexpr int MT = (BN == 256) ? 8 : 4, WM = MT * 16;
  constexpr int TA = 256 * 64 * 2, TB = BN * 64 * 2, STAGE = 65536;
  constexpr int GLA = 4, GLB = TB / 8192;
  const int tid = otid(), wid = tid >> 6, lane = tid & 63, fr = lane & 15, fq = lane >> 4;
  const int wr = (BN == 256) ? (wid >> 2) : (wid >> 1), wc = (BN == 256) ? (wid & 3) : (wid & 1);
  int total = 0;
  for (int s_ = 0; s_ < nseg; ++s_) { const u16 *a_, *b_; int la_, lb_, nk_; seg(s_, a_, la_, b_, lb_, nk_); total += nk_; }
  int ps = 0, pk = 0, pnk, plda, pldb;
  const u16 *pA, *pB;
  seg(0, pA, plda, pB, pldb, pnk);
  unsigned oa[GLA], ob[GLB];
#define S_OFFS() do { _Pragma("unroll") for (int i = 0; i < GLA; ++i) { int R_, C_; stage_rc2(wid * 1024 + i * 8192 + lane * 16, R_, C_); \
      oa[i] = (unsigned)(R_ * plda + C_) * 2u; if (i < GLB) ob[i] = (unsigned)(R_ * pldb + C_) * 2u; } } while (0)
  S_OFFS();
  int cs = 0, ck = 0, cnk = pnk;
  char* wbase = shm + (wid & 7) * 1024;
#define S_STAGE(buf) do { \
    const char* ak_ = (const char*)pA + pk * 128; \
    const char* bk_ = (const char*)pB + pk * 128; \
    _Pragma("unroll") for (int i = 0; i < GLA; ++i) \
      __builtin_amdgcn_global_load_lds((const unsigned*)(ak_ + oa[i]), (unsigned*)(wbase + (buf) * STAGE + i * 8192), 16, 0, 0); \
    _Pragma("unroll") for (int i = 0; i < GLB; ++i) \
      __builtin_amdgcn_global_load_lds((const unsigned*)(bk_ + ob[i]), (unsigned*)(wbase + (buf) * STAGE + TA + i * 8192), 16, 0, 0); \
    if (++pk == pnk) { pk = 0; if (++ps < nseg) { seg(ps, pA, plda, pB, pldb, pnk); S_OFFS(); } } } while (0)
  __syncthreads();
  S_STAGE(0);
  asm volatile("s_waitcnt vmcnt(0)" ::: "memory");
  __syncthreads();
#define S_BODY(cur) do { \
    if (g + 1 < total) S_STAGE((cur) ^ 1); \
    const char* sA = shm + (cur) * STAGE; \
    const char* sB = sA + TA; \
    _Pragma("unroll") for (int ks = 0; ks < 2; ++ks) { \
      bf16x8 At[MT], Bf[4]; \
      _Pragma("unroll") for (int m = 0; m < MT; ++m) At[m] = *(const bf16x8*)(sA + (lds_byte2(wr * WM + m * 16 + fr, ks * 32 + fq * 8) & 0x7FFF)); \
      _Pragma("unroll") for (int n = 0; n < 4; ++n) Bf[n] = *(const bf16x8*)(sB + (lds_byte2(wc * 64 + n * 16 + fr, ks * 32 + fq * 8) & 0x7FFF)); \
      _Pragma("unroll") for (int m = 0; m < MT; ++m) \
        _Pragma("unroll") for (int n = 0; n < 4; ++n) acc[m][n] = __builtin_amdgcn_mfma_f32_16x16x32_bf16(Bf[n], At[m], acc[m][n], 0, 0, 0); \
      __builtin_amdgcn_sched_group_barrier(0x100, 6, 0); \
      _Pragma("unroll") for (int m = 0; m < MT; ++m) { \
        __builtin_amdgcn_sched_group_barrier(0x008, 4, 0); \
        if (m + 2 < MT) __builtin_amdgcn_sched_group_barrier(0x100, 1, 0); \
      } \
    } \
    if (++ck == cnk) { \
      endf(cs, acc); \
      _Pragma("unroll") for (int m = 0; m < MT; ++m) \
        _Pragma("unroll") for (int n = 0; n < 4; ++n) acc[m][n] = f32x4{0.f, 0.f, 0.f, 0.f}; \
      ck = 0; \
      if (++cs < nseg) { const u16 *a_, *b_; int la_, lb_; seg(cs, a_, la_, b_, lb_, cnk); } \
    } \
    asm volatile("s_waitcnt vmcnt(0)" ::: "memory"); \
    __syncthreads(); \
    ++g; } while (0)
  for (int g = 0; g < total;) {
    S_BODY(0);
    if (g < total) S_BODY(1);
  }
#undef S_BODY
#undef S_STAGE
#undef S_OFFS
}

#define EPI256(BN_) const int tid_ = otid(), wid_ = tid_ >> 6, lane_ = tid_ & 63, fr_ = lane_ & 15, fq_ = lane_ >> 4, \
    wr_ = ((BN_) == 256) ? (wid_ >> 2) : (wid_ >> 1), wc_ = ((BN_) == 256) ? (wid_ & 3) : (wid_ & 1), wm_ = ((BN_) == 256) ? 128 : 64
#define E256_ROW(m) (wr_ * wm_ + (m) * 16 + fr_)
#define E256_COL(n) (wc_ * 64 + (n) * 16 + fq_ * 4)

__device__ __forceinline__ void conv_transpose(const float* __restrict__ src, int K, int N, u16* __restrict__ dst, float* tile) {
  const int tid = otid(), lane = tid & 63, w = tid >> 6;
  const int ntn = N >> 8, nt = (K >> 6) * ntn;
  for (int t = blockIdx.x; t < nt; t += gridDim.x) {
    const int k0 = (t / ntn) << 6, n0 = (t % ntn) << 8;
    const float* sp = src + (size_t)(k0 + w * 8) * N + n0 + lane * 4;
    const float4 v0 = *(const float4*)(sp), v1 = *(const float4*)(sp + (size_t)N), v2 = *(const float4*)(sp + (size_t)2 * N), v3 = *(const float4*)(sp + (size_t)3 * N);
    const float4 v4 = *(const float4*)(sp + (size_t)4 * N), v5 = *(const float4*)(sp + (size_t)5 * N), v6 = *(const float4*)(sp + (size_t)6 * N), v7 = *(const float4*)(sp + (size_t)7 * N);
    __syncthreads();
    float* tw = tile + (w * 8) * 260 + lane * 4;
    *(float4*)(tw) = v0; *(float4*)(tw + 260) = v1; *(float4*)(tw + 520) = v2; *(float4*)(tw + 780) = v3;
    *(float4*)(tw + 1040) = v4; *(float4*)(tw + 1300) = v5; *(float4*)(tw + 1560) = v6; *(float4*)(tw + 1820) = v7;
    __syncthreads();
    const int kg = tid & 7;
#pragma unroll
    for (int i = 0; i < 4; ++i) {
      const int n = (tid >> 3) + i * 64;
      const float* tp = tile + (kg * 8) * 260 + n;
      uint4 o;
      o.x = pack2(tp[0], tp[260]); o.y = pack2(tp[2 * 260], tp[3 * 260]);
      o.z = pack2(tp[4 * 260], tp[5 * 260]); o.w = pack2(tp[6 * 260], tp[7 * 260]);
      *(uint4*)(dst + (size_t)(n0 + n) * K + k0 + kg * 8) = o;
    }
  }
}

__device__ __forceinline__ void s5_item(const Params& p, int layer, int rd, int bi, int pass, u16* smem) {
  const int tid = otid(), lane = tid & 63, wid = tid >> 6, fr = lane & 15, fq = lane >> 4;
  const int w = bi * 8 + wid;
  const int lu = w >> 10, rem = w & 1023, d = rem & 1, g = (rem >> 1) & 31, ss = rem >> 6;
  const int unit = rd * 3 + lu;
  const bool ctx = (unit == 0);
  const int L = ctx ? 256 : 4096;
  const int seq = ctx ? ss : 0, seg = ctx ? 0 : ss;
  const int rowbase = lu * 4096 + seq * L;
  const u16* proj = (const u16*)(p.ws + OFF_PROJ);
  float* bul = (float*)smem + wid * 2560;
  u16* Hs = smem + 40960 + wid * (16 * 136);
  const int pg = ((layer * 2 + d) * 32 + g);
  const float step = __expf(p.in[17][pg]);
  float lbr, lbi;
  {
    const float lre = p.in[15][pg * 64 + lane], lim = p.in[16][pg * 64 + lane];
    const float mag = __expf(lre * step);
    lbr = mag * __cosf(lim * step); lbi = mag * __sinf(lim * step);
  }
  bf16x8 bbf[8], bbl[8];
#pragma unroll
  for (int q = 0; q < 4; ++q) {
    const int n = q * 16 + fr;
    const float lre = p.in[15][pg * 64 + n], lim = p.in[16][pg * 64 + n];
    const float mag = __expf(lre * step);
    const float br_ = mag * __cosf(lim * step), bi_ = mag * __sinf(lim * step);
    const float nr = br_ - 1.f, den = lre * lre + lim * lim;
    const float fre = (nr * lre + bi_ * lim) / den, fim = (bi_ * lre - nr * lim) / den;
    const float* br = p.in[18] + ((size_t)pg * 64 + n) * 16 + (fq & 1) * 8;
    const float* bim = p.in[19] + ((size_t)pg * 64 + n) * 16 + (fq & 1) * 8;
    const float msk = (fq < 2) ? 1.f : 0.f;
    u32x4 ure, uim, lre_, lim_;
#pragma unroll
    for (int i = 0; i < 4; ++i) {
      const float a0 = br[2 * i] * msk, b0 = bim[2 * i] * msk, a1 = br[2 * i + 1] * msk, b1 = bim[2 * i + 1] * msk;
      const float r0 = fre * a0 - fim * b0, r1 = fre * a1 - fim * b1, m0 = fre * b0 + fim * a0, m1 = fre * b1 + fim * a1;
      ure[i] = pack2(r0, r1);
      uim[i] = pack2(m0, m1);
      lre_[i] = pack2(r0 - bflo(ure[i]), r1 - bfhi(ure[i]));
      lim_[i] = pack2(m0 - bflo(uim[i]), m1 - bfhi(uim[i]));
    }
    bbf[q] = __builtin_bit_cast(bf16x8, ure);
    bbf[4 + q] = __builtin_bit_cast(bf16x8, uim);
    bbl[q] = __builtin_bit_cast(bf16x8, lre_);
    bbl[4 + q] = __builtin_bit_cast(bf16x8, lim_);
  }
  float hr = 0.f, hi = 0.f;
  bf16x8 cf[4];
  u16* ysd = (u16*)(p.ws + OFF_YS) + (size_t)d * RR * 512;
  float* loc = (float*)(p.ws + OFF_S5LOC);
  if (pass == 2) {
    if (!ctx) {
      const size_t si = ((((size_t)(unit - 1) * 2 + layer) * 2 + d) * 32 + g) * 64 + lane;
      hr = p.in[5][si]; hi = p.in[6][si];
    }
    float ar = lbr, ai = lbi;
#pragma unroll
    for (int i = 0; i < 8; ++i) { float t = ar * ar - ai * ai; ai = 2.f * ar * ai; ar = t; }
    for (int i = 0; i < seg; ++i) {
      const int wi = (lu << 10) + (i << 6) + (g << 1) + d;
      const float lr_ = loc[(size_t)wi * 128 + lane], li_ = loc[(size_t)wi * 128 + 64 + lane];
      const float t = ar * hr - ai * hi + lr_;
      hi = ar * hi + ai * hr + li_;
      hr = t;
    }
    const float* cre = p.in[20] + ((size_t)pg * 16 + fr) * 64;
    const float* cim = p.in[21] + ((size_t)pg * 16 + fr) * 64;
#pragma unroll
    for (int ks = 0; ks < 4; ++ks) {
      const float* src = (ks < 2) ? (cre + ks * 32 + fq * 8) : (cim + (ks - 2) * 32 + fq * 8);
      const float sg = (ks < 2) ? 1.f : -1.f;
      u32x4 uc;
#pragma unroll
      for (int i = 0; i < 4; ++i) uc[i] = pack2(sg * src[2 * i], sg * src[2 * i + 1]);
      cf[ks] = __builtin_bit_cast(bf16x8, uc);
    }
  }
  auto load_u = [&](int sbg) -> u32x4 {
    const int pos = seg * 256 + sbg * 16 + fr;
    const int l = d ? (L - 1 - pos) : pos;
    u32x4 v = *(const u32x4*)(proj + (size_t)(rowbase + l) * PS + C_UB + g * 16 + (fq & 1) * 8);
    if (fq >= 2) v = u32x4{0u, 0u, 0u, 0u};
    return v;
  };
  u32x4 unext = load_u(0);
  for (int sbg = 0; sbg < 16; ++sbg) {
    const bf16x8 uf = __builtin_bit_cast(bf16x8, unext);
    if (sbg + 1 < 16) unext = load_u(sbg + 1);
#pragma unroll
    for (int nt = 0; nt < 8; ++nt) {
      f32x4 a = f32x4{0.f, 0.f, 0.f, 0.f};
      a = __builtin_amdgcn_mfma_f32_16x16x32_bf16(uf, bbl[nt], a, 0, 0, 0);
      a = __builtin_amdgcn_mfma_f32_16x16x32_bf16(uf, bbf[nt], a, 0, 0, 0);
      *(f32x4*)(bul + (nt * 16 + fr) * 20 + fq * 4) = a;
    }
    asm volatile("s_waitcnt lgkmcnt(0)" ::: "memory"); __builtin_amdgcn_wave_barrier();
    float bre[16], bim_[16];
#pragma unroll
    for (int k = 0; k < 4; ++k) {
      const f32x4 x = *(const f32x4*)(bul + lane * 20 + k * 4), y = *(const f32x4*)(bul + (64 + lane) * 20 + k * 4);
      bre[4 * k] = x[0]; bre[4 * k + 1] = x[1]; bre[4 * k + 2] = x[2]; bre[4 * k + 3] = x[3];
      bim_[4 * k] = y[0]; bim_[4 * k + 1] = y[1]; bim_[4 * k + 2] = y[2]; bim_[4 * k + 3] = y[3];
    }
    asm volatile("s_waitcnt lgkmcnt(0)" ::: "memory"); __builtin_amdgcn_wave_barrier();
#pragma unroll
    for (int s2 = 0; s2 < 16; ++s2) {
      const float t = lbr * hr - lbi * hi + bre[s2];
      hi = lbr * hi + lbi * hr + bim_[s2];
      hr = t;
      if (pass == 2) { Hs[s2 * 136 + lane] = f2bf(hr); Hs[s2 * 136 + 64 + lane] = f2bf(hi); }
    }
    if (pass == 2) {
      asm volatile("s_waitcnt lgkmcnt(0)" ::: "memory"); __builtin_amdgcn_wave_barrier();
      f32x4 ya = f32x4{0.f, 0.f, 0.f, 0.f};
#pragma unroll
      for (int ks = 0; ks < 4; ++ks) {
        const bf16x8 hf = *(const bf16x8*)(Hs + fr * 136 + ks * 32 + fq * 8);
        ya = __builtin_amdgcn_mfma_f32_16x16x32_bf16(hf, cf[ks], ya, 0, 0, 0);
      }
#pragma unroll
      for (int j = 0; j < 4; ++j) {
        const int pos = seg * 256 + sbg * 16 + fq * 4 + j;
        const int l = d ? (L - 1 - pos) : pos;
        ysd[(size_t)(rowbase + l) * 512 + g * 16 + fr] = f2bf(ya[j]);
      }
      asm volatile("s_waitcnt lgkmcnt(0)" ::: "memory"); __builtin_amdgcn_wave_barrier();
    }
  }
  if (pass == 1) {
    loc[(size_t)w * 128 + lane] = hr;
    loc[(size_t)w * 128 + 64 + lane] = hi;
  } else if (ctx) {
    const size_t oi = ((((size_t)seq * 2 + layer) * 2 + d) * 32 + g) * 64 + lane;
    p.out[OS5R + oi] = hr;
    p.out[OS5I + oi] = hi;
  }
}

__device__ __forceinline__ void hgrnA_item(const Params& p, int layer, int gc, int h, char* shm) {
  const int tid = otid(), lane = tid & 63, w = tid >> 6, fr = lane & 15, fq = lane >> 4;
  const int d = tid & 127, tq = tid >> 7;
  const u16* proj = (const u16*)(p.ws + OFF_PROJ);
  u16* Qm = (u16*)shm;
  u16* Km = (u16*)(shm + 17408);
  u16* KlT = (u16*)(shm + 34816);
  u16* VT = (u16*)(shm + 53248);
  u16* Pm = (u16*)(shm + 71680);
  float* tot = (float*)(shm + 80896);
  const int rowb = gc * 64;
  for (int dir = 0; dir < 2; ++dir) {
    float lb = 0.f;
    if (layer == 1) {
      const int ci = dir * 512 + h * 128 + d;
      const float l0 = p.in[27][ci], l1 = p.in[27][1024 + ci];
      lb = 1.f / (1.f + __expf(l0 - l1));
    }
    float cl[16], kk[16], qv[16];
    float c = 0.f;
    const int zc = (dir ? C_ZB : C_ZF) + h * 128 + d;
    u16 rz[16], rq[16], rvv[16];
#pragma unroll
    for (int i = 0; i < 16; ++i) {
      const int t = tq * 16 + i;
      const size_t ro = (size_t)(rowb + (dir ? 63 - t : t)) * PS;
      rz[i] = proj[ro + zc];
      rq[i] = proj[ro + C_QD + h * 128 + d];
      rvv[i] = proj[ro + C_ID + h * 128 + d];
    }
    __builtin_amdgcn_sched_barrier(0);
    __syncthreads();
#pragma unroll
    for (int i = 0; i < 16; ++i) {
      const int t = tq * 16 + i;
      const float z = bf2f(rz[i]);
      const float f = lb + (1.f - lb) * sigm(z);
      kk[i] = 1.f - f;
      c += __logf(fmaxf(f, 1e-30f));
      cl[i] = c;
      qv[i] = bf2f(rq[i]);
      VT[d * 72 + t] = rvv[i];
    }
    tot[tq * 128 + d] = c;
    __syncthreads();
    const float t0 = tot[d], t1 = tot[128 + d], t2 = tot[256 + d], t3 = tot[384 + d];
    const float off = (tq == 0) ? 0.f : (tq == 1) ? t0 : (tq == 2) ? (t0 + t1) : (t0 + t1 + t2);
    const float mref = t0 + t1, last = t0 + t1 + t2 + t3;
    u16* qib = (u16*)(p.ws + OFF_QIB) + (size_t)dir * RR * 512;
#pragma unroll
    for (int i = 0; i < 16; ++i) {
      const int t = tq * 16 + i;
      const int row = rowb + (dir ? 63 - t : t);
      const float cum = off + cl[i];
      qib[(size_t)row * 512 + h * 128 + d] = f2bf(qv[i] * __expf(cum));
      Qm[t * 136 + d] = f2bf(qv[i] * __expf(fminf(cum - mref, 80.f)));
      Km[t * 136 + d] = f2bf(kk[i] * __expf(fminf(mref - cum, 80.f)));
      KlT[d * 72 + t] = f2bf(kk[i] * __expf(last - cum));
    }
    if (tq == 0) ((float*)(p.ws + OFF_DEC))[((size_t)(dir * 192 + gc) * 4 + h) * 128 + d] = __expf(last);
    __syncthreads();
    {
      const int mt = w >> 1;
#pragma unroll
      for (int nn = 0; nn < 2; ++nn) {
        const int nt = (w & 1) * 2 + nn;
        f32x4 a = f32x4{0.f, 0.f, 0.f, 0.f};
#pragma unroll
        for (int ks = 0; ks < 4; ++ks) {
          const bf16x8 mf = *(const bf16x8*)(Qm + (mt * 16 + fr) * 136 + ks * 32 + fq * 8);
          const bf16x8 nf = *(const bf16x8*)(Km + (nt * 16 + fr) * 136 + ks * 32 + fq * 8);
          a = __builtin_amdgcn_mfma_f32_16x16x32_bf16(nf, mf, a, 0, 0, 0);
        }
        const int t = mt * 16 + fr, s0 = nt * 16 + fq * 4;
        const float p0 = (s0 + 0 <= t) ? a[0] : 0.f, p1 = (s0 + 1 <= t) ? a[1] : 0.f;
        const float p2 = (s0 + 2 <= t) ? a[2] : 0.f, p3 = (s0 + 3 <= t) ? a[3] : 0.f;
        *(uint2*)(Pm + t * 72 + s0) = uint2{pack2(p0, p1), pack2(p2, p3)};
      }
    }
    __syncthreads();
    {
      const int mt = w & 3, ntb = (w >> 2) * 4;
      u16* og = (u16*)(p.ws + OFF_OHG) + (size_t)dir * RR * 512;
      const int t = mt * 16 + fr;
      const int row = rowb + (dir ? 63 - t : t);
      bf16x8 mf0 = *(const bf16x8*)(Pm + t * 72 + fq * 8), mf1 = *(const bf16x8*)(Pm + t * 72 + 32 + fq * 8);
#pragma unroll
      for (int nn = 0; nn < 4; ++nn) {
        const int nt = ntb + nn;
        f32x4 a = f32x4{0.f, 0.f, 0.f, 0.f};
        const bf16x8 nf0 = *(const bf16x8*)(VT + (nt * 16 + fr) * 72 + fq * 8), nf1 = *(const bf16x8*)(VT + (nt * 16 + fr) * 72 + 32 + fq * 8);
        a = __builtin_amdgcn_mfma_f32_16x16x32_bf16(nf0, mf0, a, 0, 0, 0);
        a = __builtin_amdgcn_mfma_f32_16x16x32_bf16(nf1, mf1, a, 0, 0, 0);
        *(uint2*)(og + (size_t)row * 512 + h * 128 + nt * 16 + fq * 4) = uint2{pack2(a[0], a[1]), pack2(a[2], a[3])};
      }
    }
    {
      const int mt = w;
      u16* ds = (u16*)(p.ws + OFF_DS) + ((size_t)(dir * 192 + gc) * 4 + h) * 16384;
      const bf16x8 mf0 = *(const bf16x8*)(VT + (mt * 16 + fr) * 72 + fq * 8), mf1 = *(const bf16x8*)(VT + (mt * 16 + fr) * 72 + 32 + fq * 8);
#pragma unroll
      for (int nt = 0; nt < 8; ++nt) {
        f32x4 a = f32x4{0.f, 0.f, 0.f, 0.f};
        const bf16x8 nf0 = *(const bf16x8*)(KlT + (nt * 16 + fr) * 72 + fq * 8), nf1 = *(const bf16x8*)(KlT + (nt * 16 + fr) * 72 + 32 + fq * 8);
        a = __builtin_amdgcn_mfma_f32_16x16x32_bf16(nf0, mf0, a, 0, 0, 0);
        a = __builtin_amdgcn_mfma_f32_16x16x32_bf16(nf1, mf1, a, 0, 0, 0);
        *(uint2*)(ds + (size_t)(mt * 16 + fr) * 128 + nt * 16 + fq * 4) = uint2{pack2(a[0], a[1]), pack2(a[2], a[3])};
      }
    }
  }
  __syncthreads();
}

__device__ __forceinline__ void hgrnB2_item(const Params& p, int layer, int gc, int hp) {
  const int tid = otid(), lane = tid & 63, w = tid >> 6, fr = lane & 15, fq = lane >> 4;
  const int mt = w & 3, h = hp * 2 + (w >> 2);
  const size_t row = (size_t)gc * 64 + mt * 16 + fr;
  const u16* qib = (const u16*)(p.ws + OFF_QIB);
  const u16* dsb = (const u16*)(p.ws + OFF_DS);
  f32x4 acc[8];
#pragma unroll
  for (int nt = 0; nt < 8; ++nt) acc[nt] = f32x4{0.f, 0.f, 0.f, 0.f};
#pragma unroll
  for (int dir = 0; dir < 2; ++dir) {
    const u16* qrow = qib + ((size_t)dir * RR + row) * 512 + h * 128 + fq * 8;
    const u16* sT = dsb + ((size_t)(dir * 192 + gc) * 4 + h) * 16384 + (size_t)fr * 128 + fq * 8;
    bf16x8 mf[4];
#pragma unroll
    for (int ks = 0; ks < 4; ++ks) mf[ks] = *(const bf16x8*)(qrow + ks * 32);
    bf16x8 nfa[8], nfb[8];
#pragma unroll
    for (int nt = 0; nt < 8; ++nt) nfa[nt] = *(const bf16x8*)(sT + (size_t)nt * 16 * 128);
#pragma unroll
    for (int nt = 0; nt < 8; ++nt) nfb[nt] = *(const bf16x8*)(sT + (size_t)nt * 16 * 128 + 32);
    __builtin_amdgcn_sched_barrier(0);
#pragma unroll
    for (int nt = 0; nt < 8; ++nt) acc[nt] = __builtin_amdgcn_mfma_f32_16x16x32_bf16(nfa[nt], mf[0], acc[nt], 0, 0, 0);
#pragma unroll
    for (int nt = 0; nt < 8; ++nt) nfa[nt] = *(const bf16x8*)(sT + (size_t)nt * 16 * 128 + 64);
    __builtin_amdgcn_sched_barrier(0);
#pragma unroll
    for (int nt = 0; nt < 8; ++nt) acc[nt] = __builtin_amdgcn_mfma_f32_16x16x32_bf16(nfb[nt], mf[1], acc[nt], 0, 0, 0);
#pragma unroll
    for (int nt = 0; nt < 8; ++nt) nfb[nt] = *(const bf16x8*)(sT + (size_t)nt * 16 * 128 + 96);
    __builtin_amdgcn_sched_barrier(0);
#pragma unroll
    for (int nt = 0; nt < 8; ++nt) acc[nt] = __builtin_amdgcn_mfma_f32_16x16x32_bf16(nfa[nt], mf[2], acc[nt], 0, 0, 0);
#pragma unroll
    for (int nt = 0; nt < 8; ++nt) acc[nt] = __builtin_amdgcn_mfma_f32_16x16x32_bf16(nfb[nt], mf[3], acc[nt], 0, 0, 0);
  }
  const u16* og0 = (const u16*)(p.ws + OFF_OHG) + row * 512 + h * 128 + fq * 4;
  const u16* og1 = og0 + (size_t)RR * 512;
  float ss = 0.f;
  uint2 o0s[8], o1s[8];
#pragma unroll
  for (int nt = 0; nt < 8; ++nt) { o0s[nt] = *(const uint2*)(og0 + nt * 16); o1s[nt] = *(const uint2*)(og1 + nt * 16); }
  __builtin_amdgcn_sched_barrier(0);
#pragma unroll
  for (int nt = 0; nt < 8; ++nt) {
    const f32x4 a0 = f32x4{bflo(o0s[nt].x), bfhi(o0s[nt].x), bflo(o0s[nt].y), bfhi(o0s[nt].y)};
    const f32x4 a1 = f32x4{bflo(o1s[nt].x), bfhi(o1s[nt].x), bflo(o1s[nt].y), bfhi(o1s[nt].y)};
    acc[nt] += a0 + a1;
    ss += acc[nt][0] * acc[nt][0] + acc[nt][1] * acc[nt][1] + acc[nt][2] * acc[nt][2] + acc[nt][3] * acc[nt][3];
  }
  ss = rowsum4(ss);
  const float inv = rsqrtf(ss * (1.f / 128.f) + 1e-6f);
  const u16* proj = (const u16*)(p.ws + OFF_PROJ);
  u16* Z = (u16*)(p.ws + OFF_Z);
  float4 gns[8]; uint2 ggs[8];
#pragma unroll
  for (int nt = 0; nt < 8; ++nt) {
    const int e = nt * 16 + fq * 4;
    gns[nt] = *(const float4*)(p.in[28] + (size_t)layer * 128 + e);
    ggs[nt] = *(const uint2*)(proj + row * PS + C_GD + h * 128 + e);
  }
  __builtin_amdgcn_sched_barrier(0);
#pragma unroll
  for (int nt = 0; nt < 8; ++nt) {
    const int e = nt * 16 + fq * 4;
    const float4 gn = gns[nt];
    const uint2 gg = ggs[nt];
    const float r0 = acc[nt][0] * inv * gn.x * silu(bflo(gg.x)), r1 = acc[nt][1] * inv * gn.y * silu(bfhi(gg.x));
    const float r2 = acc[nt][2] * inv * gn.z * silu(bflo(gg.y)), r3 = acc[nt][3] * inv * gn.w * silu(bfhi(gg.y));
    *(uint2*)(Z + row * ZS + Z_D + h * 128 + e) = uint2{pack2(r0, r1), pack2(r2, r3)};
  }
}

__device__ __forceinline__ void attn_item(const Params& p, int unit, int lu, int seq, int head, int qb, u16* smem) {
  const int tid = otid(), lane = tid & 63, wid = tid >> 6, fr = lane & 15, fq = lane >> 4;
  const bool ctx = (unit == 0);
  const int L = ctx ? 256 : 4096;
  const int nkeys = ctx ? 256 : NKMAX;
  const int hkv = head >> 2;
  const int qrow0 = lu * 4096 + seq * L + qb * 256 + wid * 32;
  const u16* Qb = (const u16*)(p.ws + OFF_QB);
  const u16* Kg = (const u16*)(p.ws + OFF_KB) + ((size_t)lu * NKMAX + (ctx ? seq * 256 : 0)) * 256 + hkv * 128;
  const u16* Vg = (const u16*)(p.ws + OFF_VT) + (size_t)lu * 256 * NKMAX + (ctx ? (size_t)(seq * 2 + hkv) * 128 * 256 : (size_t)hkv * 128 * NKMAX);
  bf16x8 qf[2][4];
#pragma unroll
  for (int nt = 0; nt < 2; ++nt)
#pragma unroll
    for (int ks = 0; ks < 4; ++ks)
      qf[nt][ks] = *(const bf16x8*)(Qb + (size_t)(qrow0 + nt * 16 + fr) * 1024 + head * 128 + ks * 32 + fq * 8);
  f32x4 OT[8][2];
#pragma unroll
  for (int a = 0; a < 8; ++a) { OT[a][0] = f32x4{0.f, 0.f, 0.f, 0.f}; OT[a][1] = f32x4{0.f, 0.f, 0.f, 0.f}; }
  float mrun[2] = {0.f, 0.f}, lrun[2] = {0.f, 0.f};
  const int ntile = nkeys >> 6;
  uint4 rk0, rk1, rv0, rv1;
  const int kkey = tid >> 4, kdc = (tid & 15) * 8;
  const int vd = tid >> 3, vkc = (tid & 7) * 8;
#define ATT_ISSUE(kt_) do { \
    const u16* kp_ = Kg + (size_t)((kt_) * 64 + kkey) * 256 + kdc; \
    const u16* vp_ = Vg + (size_t)vd * nkeys + (kt_) * 64 + vkc; \
    rk0 = *(const uint4*)(kp_); rk1 = *(const uint4*)(kp_ + 32 * 256); \
    rv0 = *(const uint4*)(vp_); rv1 = *(const uint4*)(vp_ + (size_t)64 * nkeys); \
  } while (0)
#define ATT_WRITE(buf_) do { u16* ks_ = smem + (buf_) * 17920; u16* vs_ = ks_ + 64 * 136; \
    *(uint4*)(ks_ + (kkey) * 136 + kdc) = rk0; *(uint4*)(ks_ + (kkey + 32) * 136 + kdc) = rk1; \
    *(uint4*)(vs_ + (vd) * 72 + vkc) = rv0; *(uint4*)(vs_ + (vd + 64) * 72 + vkc) = rv1; } while (0)
  ATT_ISSUE(0);
  __syncthreads();
  ATT_WRITE(0);
  if (ntile > 1) ATT_ISSUE(1);
  __syncthreads();
  for (int kt = 0; kt < ntile; ++kt) {
    const u16* Ks = smem + (kt & 1) * 17920;
    const u16* Vs = Ks + 64 * 136;
    f32x4 ST[4][2];
#pragma unroll
    for (int a = 0; a < 4; ++a) {
      ST[a][0] = f32x4{-mrun[0], -mrun[0], -mrun[0], -mrun[0]};
      ST[a][1] = f32x4{-mrun[1], -mrun[1], -mrun[1], -mrun[1]};
    }
#pragma unroll
    for (int ks = 0; ks < 4; ++ks) {
#pragma unroll
      for (int mt = 0; mt < 4; ++mt) {
        const bf16x8 kf = *(const bf16x8*)(Ks + (mt * 16 + fr) * 136 + ks * 32 + fq * 8);
        ST[mt][0] = __builtin_amdgcn_mfma_f32_16x16x32_bf16(kf, qf[0][ks], ST[mt][0], 0, 0, 0);
        ST[mt][1] = __builtin_amdgcn_mfma_f32_16x16x32_bf16(kf, qf[1][ks], ST[mt][1], 0, 0, 0);
      }
    }
    u32x4 pfu[2][2];
#pragma unroll
    for (int nt = 0; nt < 2; ++nt) {
      float mx = fmaxf(fmaxf(ST[0][nt][0], ST[0][nt][1]), fmaxf(ST[0][nt][2], ST[0][nt][3]));
#pragma unroll
      for (int mt = 1; mt < 4; ++mt) mx = fmaxf(mx, fmaxf(fmaxf(ST[mt][nt][0], ST[mt][nt][1]), fmaxf(ST[mt][nt][2], ST[mt][nt][3])));
      mx = rowmax4(mx);
      const bool need = (kt == 0) || (mx > 8.f);
      if (__any(need)) {
        const float delta = need ? mx : 0.f;
        const float alpha = __builtin_amdgcn_exp2f(-delta);
        mrun[nt] += delta;
        lrun[nt] *= alpha;
#pragma unroll
        for (int mt = 0; mt < 4; ++mt) ST[mt][nt] -= delta;
#pragma unroll
        for (int dt = 0; dt < 8; ++dt) OT[dt][nt] *= alpha;
      }
      float ps = 0.f;
#pragma unroll
      for (int mt = 0; mt < 4; ++mt) {
        const float p0 = __builtin_amdgcn_exp2f(ST[mt][nt][0]), p1 = __builtin_amdgcn_exp2f(ST[mt][nt][1]);
        const float p2 = __builtin_amdgcn_exp2f(ST[mt][nt][2]), p3 = __builtin_amdgcn_exp2f(ST[mt][nt][3]);
        ps += (p0 + p1) + (p2 + p3);
        pfu[nt][mt >> 1][(mt & 1) * 2 + 0] = pack2(p0, p1);
        pfu[nt][mt >> 1][(mt & 1) * 2 + 1] = pack2(p2, p3);
      }
      lrun[nt] += ps;
    }
    if (kt + 1 < ntile) ATT_WRITE((kt + 1) & 1);
    if (kt + 2 < ntile) ATT_ISSUE(kt + 2);
#pragma unroll
    for (int kk = 0; kk < 2; ++kk) {
      const bf16x8 pf0 = __builtin_bit_cast(bf16x8, pfu[0][kk]), pf1 = __builtin_bit_cast(bf16x8, pfu[1][kk]);
#pragma unroll
      for (int dt = 0; dt < 8; ++dt) {
        const u16* vrow = Vs + (dt * 16 + fr) * 72 + kk * 32 + fq * 4;
        const uint2 v0 = *(const uint2*)(vrow), v1 = *(const uint2*)(vrow + 16);
        const bf16x8 vf = __builtin_bit_cast(bf16x8, (u32x4){v0.x, v0.y, v1.x, v1.y});
        OT[dt][0] = __builtin_amdgcn_mfma_f32_16x16x32_bf16(vf, pf0, OT[dt][0], 0, 0, 0);
        OT[dt][1] = __builtin_amdgcn_mfma_f32_16x16x32_bf16(vf, pf1, OT[dt][1], 0, 0, 0);
      }
    }
    __syncthreads();
  }
  const u16* proj = (const u16*)(p.ws + OFF_PROJ);
  u16* Z = (u16*)(p.ws + OFF_Z);
#pragma unroll
  for (int nt = 0; nt < 2; ++nt) {
    const float lt = rowsum4(lrun[nt]);
    const float inv = 1.f / lt;
    const size_t row = (size_t)(qrow0 + nt * 16 + fr);
    uint2 ggs[8];
#pragma unroll
    for (int dt = 0; dt < 8; ++dt) ggs[dt] = *(const uint2*)(proj + row * PS + C_GC + head * 128 + dt * 16 + fq * 4);
    __builtin_amdgcn_sched_barrier(0);
#pragma unroll
    for (int dt = 0; dt < 8; ++dt) {
      const int dd = head * 128 + dt * 16 + fq * 4;
      const uint2 gg = ggs[dt];
      const float o0 = OT[dt][nt][0] * inv * silu(bflo(gg.x)), o1 = OT[dt][nt][1] * inv * silu(bfhi(gg.x));
      const float o2 = OT[dt][nt][2] * inv * silu(bflo(gg.y)), o3 = OT[dt][nt][3] * inv * silu(bfhi(gg.y));
      *(uint2*)(Z + row * ZS + Z_C + dd) = uint2{pack2(o0, o1), pack2(o2, o3)};
    }
  }
  __syncthreads();
}

__global__ void __launch_bounds__(512) mega(Params p) {
  __shared__ __attribute__((aligned(1024))) char shm[131072];
  u16* smem = (u16*)shm;
  __shared__ int s_slot;
  __shared__ uint4 xb_words;
  if (threadIdx.x == 0) xb_words = make_uint4(0u, 0u, 0u, 0u);
  cg::grid_group grid = cg::this_grid();
  const int bid = blockIdx.x, nb = gridDim.x;
#define PHASE_IDS const int tid = otid(), lane = tid & 63, wid = tid >> 6; const size_t gtid = (size_t)bid * 512 + tid; const int gwave = bid * 8 + wid; const int gi = wid >> 2; u16* smg = smem + gi * 20480; (void)gi; (void)smg; (void)lane; (void)gtid; (void)gwave
  const size_t gthreads = (size_t)nb * 512;
  const int nwaves = nb * 8;
  char* ws = p.ws;
#define WinT ((u16*)(p.ws + OFF_WINT))
#define WpA ((u16*)(p.ws + OFF_WPA))
#define WpB ((u16*)(p.ws + OFF_WPB))
#define WpC ((u16*)(p.ws + OFF_WPC))
#define WpD ((u16*)(p.ws + OFF_WPD))
#define WoutT ((u16*)(p.ws + OFF_WOUT))
#define GluT ((u16*)(p.ws + OFF_GLU))
#define FWt ((u16*)(p.ws + OFF_FWT))
#define DftL ((u16*)(p.ws + OFF_DFTL))
#define DftS ((u16*)(p.ws + OFF_DFTS))
#define modp ((float*)(p.ws + OFF_MODP))
#define modb ((float*)(p.ws + OFF_MOD))
#define ctr ((int*)(p.ws + OFF_CTR))
#define hbuf ((u16*)(p.ws + OFF_H))
#define proj ((u16*)(p.ws + OFF_PROJ))
#define Z ((u16*)(p.ws + OFF_Z))
#define PQt ((u16*)(p.ws + OFF_PQT))
#define ys ((u16*)(p.ws + OFF_YS))
#define yb ((u16*)(p.ws + OFF_YB))
#define Qb ((u16*)(p.ws + OFF_QB))
#define Kb ((u16*)(p.ws + OFF_KB))
#define Vt ((u16*)(p.ws + OFF_VT))
#define mixed ((u16*)(p.ws + OFF_MIXED))
#define outb ((u16*)(p.ws + OFF_OUTB))

  {
  PHASE_IDS;
  if (bid == 0) for (int i = tid; i < 1024; i += 512) ctr[i] = 0;
  if (bid == 0) for (int i = tid; i < 4096; i += 512) ((unsigned*)(p.ws + OFF_XBAR))[i] = 0u;
  for (int l = 0; l < 2; ++l) {
    conv_transpose(p.in[13] + (size_t)l * 2048 * 15360, 2048, 15360, WinT + (size_t)l * 15360 * 2048, (float*)smem);
    conv_transpose(p.in[29] + (size_t)l * 512 * 2048, 512, 2048, WpA + (size_t)l * 2048 * 512, (float*)smem);
    conv_transpose(p.in[30] + (size_t)l * 512 * 2048, 512, 2048, WpB + (size_t)l * 2048 * 512, (float*)smem);
    conv_transpose(p.in[31] + (size_t)l * 1024 * 2048, 1024, 2048, WpC + (size_t)l * 2048 * 1024, (float*)smem);
    conv_transpose(p.in[32] + (size_t)l * 512 * 2048, 512, 2048, WpD + (size_t)l * 2048 * 512, (float*)smem);
    conv_transpose(p.in[33] + (size_t)l * 2048 * 2048, 2048, 2048, WoutT + (size_t)l * 2048 * 2048, (float*)smem);
    conv_transpose(p.in[23] + (size_t)l * 512 * 512, 512, 512, GluT + (size_t)l * 512 * 512, (float*)smem);
  }
  for (size_t idx = gtid; idx < (size_t)2048 * 4096; idx += gthreads) {
    const int k = (int)(idx >> 12), l = (int)(idx & 4095);
    const int m = (k * l) & 4095;
    const float a = (float)m * (6.283185307179586f / 4096.f);
    DftL[(size_t)k * 8192 + l] = f2bf(__cosf(a) * (1.f / 64.f));
    DftL[(size_t)k * 8192 + 4096 + l] = f2bf(-__sinf(a) * (1.f / 64.f));
  }
  for (size_t idx = gtid; idx < (size_t)256 * 256; idx += gthreads) {
    const int k = (int)(idx >> 8), l = (int)(idx & 255);
    const int m = (k * l) & 255;
    const float a = (float)m * (6.283185307179586f / 256.f);
    DftS[(size_t)k * 512 + l] = f2bf(__cosf(a) * (1.f / 16.f));
    DftS[(size_t)k * 512 + 256 + l] = f2bf(-__sinf(a) * (1.f / 16.f));
  }
  for (size_t idx = gtid; idx < (size_t)2 * 4 * 256 * 128; idx += gthreads) {
    const int c = (int)(idx & 127), n = (int)((idx >> 7) & 255), lg = (int)(idx >> 15);
    const float* w = p.in[14] + (size_t)lg * 128 * 128 + (n & 127);
    float acc = 0.f;
    for (int m = 0; m < 128; ++m) {
      const float a = (float)((m * c) & 127) * (6.283185307179586f / 128.f);
      const float tr = (n < 128) ? __cosf(a) : __sinf(a);
      acc += tr * w[(size_t)m * 128];
    }
    FWt[idx] = f2bf(acc * 0.08838834764831845f);
  }
  for (int it = bid; it < 384; it += nb) {
    const int layer = it / 192, rem = it % 192, cb = rem >> 4, kc = rem & 15;
    float* sc = (float*)smem;
    __syncthreads();
    for (int idx = tid; idx < 9 * 128; idx += 512) {
      const int u = idx >> 7, k = idx & 127;
      const float cv = (u == 0) ? p.in[8][kc * 128 + k] : p.in[2][(size_t)(u - 1) * 2048 + kc * 128 + k];
      sc[idx] = silu(cv);
    }
    __syncthreads();
    const int col = cb * 512 + tid;
    float a9[9];
#pragma unroll
    for (int u = 0; u < 9; ++u) a9[u] = 0.f;
    const float* wm = p.in[11] + ((size_t)layer * 2048 + kc * 128) * 6144 + col;
    for (int k0 = 0; k0 < 128; k0 += 16) {
      float wv[16];
#pragma unroll
      for (int j = 0; j < 16; ++j) wv[j] = wm[(size_t)(k0 + j) * 6144];
      __builtin_amdgcn_sched_barrier(0);
#pragma unroll
      for (int j = 0; j < 16; ++j)
#pragma unroll
        for (int u = 0; u < 9; ++u) a9[u] += sc[u * 128 + k0 + j] * wv[j];
    }
#pragma unroll
    for (int u = 0; u < 9; ++u) modp[((size_t)(kc * 2 + layer) * 9 + u) * 6144 + col] = a9[u];
  }
  }
  grid.sync();
  XcdBarrier xb = xcd_barrier_post((unsigned*)(p.ws + OFF_XBAR), (volatile LAS unsigned*)&xb_words);
  {
  PHASE_IDS;
  for (size_t idx = gtid; idx < (size_t)2 * 9 * 6144; idx += gthreads) {
    const int col = (int)(idx % 6144), lu_ = (int)(idx / 6144), layer = lu_ / 9;
    float a = p.in[12][(size_t)layer * 6144 + col];
    for (int kc = 0; kc < 16; ++kc) a += modp[(size_t)kc * 2 * 9 * 6144 + idx];
    modb[idx] = a;
  }
  }
  grid.sync();

  unsigned* gcnt = (unsigned*)(ctr + 1000);
  unsigned gtarget = 0u;
  for (int rd = 0; rd < 3; ++rd) {
    for (int layer = 0; layer < 2; ++layer) {
      if (layer == 0) {
      PHASE_IDS;
      for (int row = gwave; row < RR; row += nwaves) {
        const int lu = row >> 12, t = row & 4095, unit = rd * 3 + lu;
        const float4* x4 = (const float4*)x_in_row(p, layer, unit, t);
        const float* md = modb + (size_t)(layer * 9 + unit) * 6144;
        float4 v[8];
        float ss = 0.f;
#pragma unroll
        for (int i = 0; i < 8; ++i) { v[i] = x4[lane + i * 64]; ss += v[i].x * v[i].x + v[i].y * v[i].y + v[i].z * v[i].z + v[i].w * v[i].w; }
        ss = wave_sum(ss);
        const float inv = rsqrtf(ss * (1.f / 2048.f) + 1e-6f);
#pragma unroll
        for (int i = 0; i < 8; ++i) {
          const int col = (lane + i * 64) * 4;
          const float4 g = *(const float4*)(p.in[9] + (size_t)layer * 2048 + col);
          const float4 sh = *(const float4*)(md + col), sc = *(const float4*)(md + 2048 + col);
          const float h0 = v[i].x * inv * g.x * (1.f + sc.x) + sh.x, h1 = v[i].y * inv * g.y * (1.f + sc.y) + sh.y;
          const float h2 = v[i].z * inv * g.z * (1.f + sc.z) + sh.z, h3 = v[i].w * inv * g.w * (1.f + sc.w) + sh.w;
          *(uint2*)(hbuf + (size_t)row * 2048 + col) = uint2{pack2(h0, h1), pack2(h2, h3)};
        }
      }
      xcd_barrier(xb);
      }
      {
        const u16* W = WinT + (size_t)layer * 15360 * 2048;
        const int nfull = (48 * 60 / nb) * nb;
        const int ntl = nfull / nb;
        f32x4 acc[8][4];
#pragma unroll
        for (int a_ = 0; a_ < 8; ++a_)
#pragma unroll
          for (int b_ = 0; b_ < 4; ++b_) acc[a_][b_] = f32x4{0.f, 0.f, 0.f, 0.f};
        if (ntl > 0)
        gemm256_stream<256>(ntl,
          [&](int s_, const u16*& A_, int& lda_, const u16*& B_, int& ldb_, int& nk_) {
            const int t = bid + s_ * nb, mt = t % 48, nt = t / 48;
            A_ = hbuf + (size_t)mt * 256 * 2048; lda_ = 2048; B_ = W + (size_t)nt * 256 * 2048; ldb_ = 2048; nk_ = 32;
          },
          [&](int s_, f32x4 (&ac)[8][4]) {
            const int t = bid + s_ * nb, mt = t % 48, nt = t / 48;
            EPI256(256);
            const bool mg = (nt * 256 >= C_M);
#pragma unroll
            for (int m = 0; m < 8; ++m)
#pragma unroll
              for (int n = 0; n < 4; ++n) {
                f32x4 a = ac[m][n];
                if (mg) { a[0] = sigm(a[0]); a[1] = sigm(a[1]); a[2] = sigm(a[2]); a[3] = sigm(a[3]); }
                *(uint2*)(proj + (size_t)(mt * 256 + E256_ROW(m)) * PS + nt * 256 + E256_COL(n)) = uint2{pack2(a[0], a[1]), pack2(a[2], a[3])};
              }
          }, acc, shm);
        const int nhalf = (48 * 60 - nfull) * 2;
        if (bid < nhalf) {
          f32x4 acc2[4][4];
          ACC_ZERO(acc2);
          const int t = nfull + (bid >> 1), mt = t % 48, nt = t / 48, hf = bid & 1;
          gemm256_stream<128>(1,
            [&](int s_, const u16*& A_, int& lda_, const u16*& B_, int& ldb_, int& nk_) {
              A_ = hbuf + (size_t)mt * 256 * 2048; lda_ = 2048; B_ = W + ((size_t)nt * 256 + hf * 128) * 2048; ldb_ = 2048; nk_ = 32;
            },
            [&](int s_, f32x4 (&ac)[4][4]) {
              EPI256(128);
              const bool mg = (nt * 256 >= C_M);
#pragma unroll
              for (int m = 0; m < 4; ++m)
#pragma unroll
                for (int n = 0; n < 4; ++n) {
                  f32x4 a = ac[m][n];
                  if (mg) { a[0] = sigm(a[0]); a[1] = sigm(a[1]); a[2] = sigm(a[2]); a[3] = sigm(a[3]); }
                  *(uint2*)(proj + (size_t)(mt * 256 + E256_ROW(m)) * PS + nt * 256 + hf * 128 + E256_COL(n)) = uint2{pack2(a[0], a[1]), pack2(a[2], a[3])};
                }
            }, acc2, shm);
        }
      }
      xcd_barrier(xb);
      {
        PHASE_IDS;
        int* cq3 = ctr + 64 + (rd * 2 + layer);
        while (true) {
        const int it = grab(cq3, &s_slot);
        if (it >= 1752) break;
        {
        int layer_o = layer, rd_o = rd;
        asm volatile("" : "+s"(layer_o), "+s"(rd_o));
        const int layer = layer_o, rd = rd_o;
        if (it >= 1368) {
          const int t2 = it - 1368;
          const int t = t2 * 2 + gi;
          const int mt = t % 96, gn = t / 96, g = gn >> 1, nh = gn & 1;
          f32x4 acc[4][4];
          ACC_ZERO(acc);
          gemm_tile(proj + (size_t)mt * 128 * PS + C_UA + g * 128, PS, FWt + ((size_t)(layer * 4 + g) * 256 + nh * 128) * 128, 128, 128, acc, smg);
          EPI_IDX;
#pragma unroll
          for (int mi = 0; mi < 4; ++mi) {
            const int row = mt * 128 + EPI_ROW(mi);
            const int lu = row >> 12, tt = row & 4095, unit = rd * 3 + lu;
            const bool ctx = (unit == 0);
            const int L = ctx ? 256 : 4096;
            const int seq = ctx ? (tt >> 8) : 0, l = ctx ? (tt & 255) : tt;
            u16* base = PQt + (size_t)lu * 4096 * 1024 + (size_t)seq * 512 * 2 * L + (size_t)nh * L + l;
#pragma unroll
            for (int ni = 0; ni < 4; ++ni) {
              const int dcol = EPI_COL(ni);
#pragma unroll
              for (int j = 0; j < 4; ++j) base[(size_t)(g * 128 + dcol + j) * 2 * L] = f2bf(acc[ni][mi][j]);
            }
          }
        }
        if (it < 384) s5_item(p, layer, rd, it, 1, smem);
        else if (it < 1152) hgrnA_item(p, layer, (it - 384) >> 2, (it - 384) & 3, shm);
        const float qscale = 0.08838834764831845f * 1.4426950408889634f;
        if (it >= 1152 && it < 1344)
        for (int rr = 0; rr < 8; ++rr) {
          const int row = (it - 1152) * 64 + wid * 8 + rr;
          const int lu = row >> 12, t = row & 4095, unit = rd * 3 + lu;
          const bool ctx = (unit == 0);
          const int seq = ctx ? (t >> 8) : 0, l = ctx ? (t & 255) : t;
          const u16* pr = proj + (size_t)row * PS;
          const int a = lane >> 5, i = lane & 31;
          float cs = 1.f, sn = 0.f;
          if (!ctx) {
            const float pos = (float)(a == 0 ? (l >> 6) : (l & 63));
            const float ang = pos * __expf(-(float)i * (9.210340371976184f / 32.f));
            cs = __cosf(ang); sn = __sinf(ang);
          }
          u16 rx1[10], rx2[10], rvx[4];
#pragma unroll
          for (int hh = 0; hh < 10; ++hh) {
            const int cb = (hh < 8) ? (C_QC + hh * 128) : (C_KC + (hh - 8) * 128);
            rx1[hh] = pr[cb + a * 64 + i]; rx2[hh] = pr[cb + a * 64 + 32 + i];
          }
#pragma unroll
          for (int e = 0; e < 4; ++e) rvx[e] = pr[C_VC + lane + e * 64];
          __builtin_amdgcn_sched_barrier(0);
#pragma unroll
          for (int hh = 0; hh < 10; ++hh) {
            const float x1 = bf2f(rx1[hh]), x2 = bf2f(rx2[hh]);
            const float ssq = wave_sum(x1 * x1 + x2 * x2);
            const float inv = rsqrtf(ssq * (1.f / 128.f) + 1e-6f);
            const float* gn = (hh < 8) ? (p.in[25] + layer * 128) : (p.in[26] + layer * 128);
            float y1 = x1 * inv * gn[a * 64 + i], y2 = x2 * inv * gn[a * 64 + 32 + i];
            if (hh >= 8 && ctx) {
              const size_t oi = OCK + ((((size_t)seq * 2 + layer) * 256 + l) * 2 + (hh - 8)) * 128 + a * 64 + i;
              p.out[oi] = y1; p.out[oi + 32] = y2;
            }
            const float r1 = y1 * cs - y2 * sn, r2 = y2 * cs + y1 * sn;
            if (hh < 8) {
              Qb[(size_t)row * 1024 + hh * 128 + a * 64 + i] = f2bf(r1 * qscale);
              Qb[(size_t)row * 1024 + hh * 128 + a * 64 + 32 + i] = f2bf(r2 * qscale);
            } else {
              const size_t kr = (size_t)lu * NKMAX + (ctx ? (seq * 256 + l) : l);
              Kb[kr * 256 + (hh - 8) * 128 + a * 64 + i] = f2bf(r1);
              Kb[kr * 256 + (hh - 8) * 128 + a * 64 + 32 + i] = f2bf(r2);
            }
          }
#pragma unroll
          for (int e = 0; e < 4; ++e) {
            const int idx = lane + e * 64, hkv = idx >> 7, dd = idx & 127;
            const u16 vv = rvx[e];
            if (ctx) {
              p.out[OCV + ((((size_t)seq * 2 + layer) * 256 + l) * 2 + hkv) * 128 + dd] = bf2f(vv);
              Vt[(size_t)lu * 256 * NKMAX + ((size_t)(seq * 2 + hkv) * 128 + dd) * 256 + l] = vv;
            } else {
              Vt[(size_t)lu * 256 * NKMAX + ((size_t)hkv * 128 + dd) * NKMAX + l] = vv;
            }
          }
        }
        if (it >= 1344 && it < 1368) {
          float kv[8][4], vvv[8][4];
#pragma unroll
          for (int rr = 0; rr < 8; ++rr) {
            const int r = (it - 1344) * 64 + wid * 8 + rr;
            const int lu = r >> 9, j = r & 511, unit = rd * 3 + lu;
            const size_t ci = (((size_t)((unit > 0 ? unit : 1) - 1) * 2 + layer) * 512 + j) * 256;
#pragma unroll
            for (int e = 0; e < 4; ++e) { kv[rr][e] = p.in[3][ci + lane + e * 64]; vvv[rr][e] = p.in[4][ci + lane + e * 64]; }
          }
          __builtin_amdgcn_sched_barrier(0);
#pragma unroll
          for (int rr = 0; rr < 8; ++rr) {
            const int r = (it - 1344) * 64 + wid * 8 + rr;
            const int lu = r >> 9, j = r & 511, unit = rd * 3 + lu;
            if (unit != 0) {
#pragma unroll
              for (int e = 0; e < 4; ++e) {
                const int idx = lane + e * 64;
                Kb[((size_t)lu * NKMAX + 4096 + j) * 256 + idx] = f2bf(kv[rr][e]);
                Vt[(size_t)lu * 256 * NKMAX + (size_t)idx * NKMAX + 4096 + j] = f2bf(vvv[rr][e]);
              }
            }
          }
        }
        }
        }
      }
      xcd_barrier(xb);
      {
        const int nl = (rd == 0) ? 2 : 3, ncx = (rd == 0) ? 1 : 0, lu0 = ncx;
        const int n_hl = nl * 32, n_at = nl * 128, n_df = 0, n_hc = nl * 8, n_s5 = 384, n_ac = ncx * 128, n_dc = ncx * 32;
        const int e0 = n_hl, e1 = e0 + n_at, e2 = e1 + n_df, e3 = e2 + n_hc, e4 = e3 + n_s5, e5 = e4 + n_ac, e6 = e5 + n_dc;
        const int nb1 = ncx * 1024 + nl * 64;
        int* cq = ctr + (rd * 2 + layer);
        while (true) {
          int it = grab(cq, &s_slot);
          if (it >= e6 + nb1) break;
          if (it < nb1) {
            const int lu = (ncx && it < 1024) ? 0 : (ncx ? 1 + ((it - 1024) >> 6) : (it >> 6));
            const int ii = (ncx && it < 1024) ? it : (ncx ? ((it - 1024) & 63) : (it & 63));
            const int unit = rd * 3 + lu;
            const bool ctx = (unit == 0);
            const int nch = ctx ? 4 : 64;
            u16* dsb = (u16*)(p.ws + OFF_DS);
            const float* dec = (const float*)(p.ws + OFF_DEC);
            const size_t idx = (size_t)ii * 512 + otid();
            {
              const int dq = (int)(idx & 31), e = (int)((idx >> 5) & 127), h = (int)((idx >> 12) & 3), dir = (int)((idx >> 14) & 1), seq = (int)(idx >> 15);
              const int c0 = lu * 64 + seq * nch;
              float S0 = 0.f, S1 = 0.f, S2 = 0.f, S3 = 0.f;
              if (!ctx) {
                const float* st = p.in[7] + (((((size_t)(unit - 1) * 2 + layer) * 2 + dir) * 4 + h) * 128 + dq * 4) * 128 + e;
                S0 = st[0]; S1 = st[128]; S2 = st[256]; S3 = st[384];
              }
              for (int cc = 0; cc < nch; cc += 4) {
                uint2 tv[4]; float4 dc[4]; u16* ptr[4];
#pragma unroll
                for (int k = 0; k < 4; ++k) {
                  const int gc = dir ? (c0 + nch - 1 - cc - k) : (c0 + cc + k);
                  const size_t bi_ = (size_t)(dir * 192 + gc) * 4 + h;
                  ptr[k] = dsb + (bi_ * 128 + e) * 128 + dq * 4;
                  tv[k] = *(const uint2*)ptr[k];
                  dc[k] = *(const float4*)(dec + bi_ * 128 + dq * 4);
                }
#pragma unroll
                for (int k = 0; k < 4; ++k) {
                  *(uint2*)ptr[k] = uint2{pack2(S0, S1), pack2(S2, S3)};
                  S0 = dc[k].x * S0 + bflo(tv[k].x); S1 = dc[k].y * S1 + bfhi(tv[k].x);
                  S2 = dc[k].z * S2 + bflo(tv[k].y); S3 = dc[k].w * S3 + bfhi(tv[k].y);
                }
              }
              if (ctx) {
                float* o = p.out + OHG + (((((size_t)seq * 2 + layer) * 2 + dir) * 4 + h) * 128 + dq * 4) * 128 + e;
                o[0] = S0; o[128] = S1; o[256] = S2; o[384] = S3;
              }
            }
            continue;
          }
          it -= nb1;
          if (it < e0) {
            const int lu = lu0 + it / 32, r = it % 32, mt = r & 7, nt = r >> 3;
            f32x4 acc[4][4], accA[4][4];
            ACC_ZERO(acc);
            ACC_ZERO(accA);
            const u16* Bm = PQt + (size_t)lu * 4096 * 1024 + (size_t)nt * 128 * 8192;
            gemm256_stream<128>(2,
              [&](int s_, const u16*& A_, int& lda_, const u16*& B_, int& ldb_, int& nk_) {
                A_ = DftL + (size_t)mt * 256 * 8192 + s_ * 4096; lda_ = 8192; B_ = Bm + s_ * 4096; ldb_ = 8192; nk_ = 64;
              },
              [&](int s_, f32x4 (&ac)[4][4]) {
                if (s_ == 0) {
#pragma unroll
                  for (int m = 0; m < 4; ++m)
#pragma unroll
                    for (int n = 0; n < 4; ++n) accA[m][n] = ac[m][n];
                } else {
                  EPI256(128);
                  uint2 gs_[4][4];
#pragma unroll
                  for (int m = 0; m < 4; ++m)
#pragma unroll
                    for (int n = 0; n < 4; ++n)
                      gs_[m][n] = *(const uint2*)(proj + ((size_t)lu * 4096 + mt * 256 + E256_ROW(m)) * PS + C_GA + nt * 128 + E256_COL(n));
                  __builtin_amdgcn_sched_barrier(0);
#pragma unroll
                  for (int m = 0; m < 4; ++m)
#pragma unroll
                    for (int n = 0; n < 4; ++n) {
                      const size_t row = (size_t)lu * 4096 + mt * 256 + E256_ROW(m);
                      const int col = nt * 128 + E256_COL(n);
                      const uint2 gg = gs_[m][n];
                      const f32x4 a = accA[m][n] + ac[m][n];
                      *(uint2*)(Z + row * ZS + Z_A + col) = uint2{pack2(a[0] * silu(bflo(gg.x)), a[1] * silu(bfhi(gg.x))),
                                                                   pack2(a[2] * silu(bflo(gg.y)), a[3] * silu(bfhi(gg.y)))};
                    }
                  __builtin_amdgcn_sched_barrier(0);
#pragma unroll
                  for (int m = 0; m < 4; ++m)
#pragma unroll
                    for (int n = 0; n < 4; ++n)
                      gs_[m][n] = *(const uint2*)(proj + ((size_t)lu * 4096 + ((4096 - (mt * 256 + E256_ROW(m))) & 4095)) * PS + C_GA + nt * 128 + E256_COL(n));
                  __builtin_amdgcn_sched_barrier(0);
#pragma unroll
                  for (int m = 0; m < 4; ++m)
#pragma unroll
                    for (int n = 0; n < 4; ++n) {
                      const int k = mt * 256 + E256_ROW(m);
                      const int col = nt * 128 + E256_COL(n);
                      if (k > 0) {
                        const size_t row = (size_t)lu * 4096 + (4096 - k);
                        const uint2 gg = gs_[m][n];
                        const f32x4 a = accA[m][n] - ac[m][n];
                        *(uint2*)(Z + row * ZS + Z_A + col) = uint2{pack2(a[0] * silu(bflo(gg.x)), a[1] * silu(bfhi(gg.x))),
                                                                     pack2(a[2] * silu(bflo(gg.y)), a[3] * silu(bfhi(gg.y)))};
                      }
                    }
                }
              }, acc, shm);
          } else if (it < e1) {
            const int i2 = it - e0, lu = lu0 + i2 / 128, r = i2 % 128;
            attn_item(p, rd * 3 + lu, lu, 0, r >> 4, r & 15, smem);
          } else if (it < e3) {
            const int i2 = it - e2, lu = lu0 + (i2 >> 3), chg = i2 & 7;
            const int tid_ = otid(), lane_ = tid_ & 63, w_ = tid_ >> 6;
            for (int c = 0; c < 8; ++c) {
              const int ch = chg * 64 + w_ * 8 + c;
              const u16* src = PQt + (size_t)lu * 4096 * 1024 + (size_t)ch * 8192 + lane_ * 8;
              uint4 v[8];
#pragma unroll
              for (int i = 0; i < 8; ++i) v[i] = *(const uint4*)(src + i * 512);
              __builtin_amdgcn_sched_barrier(0);
              float a = 0.f;
#pragma unroll
              for (int i = 0; i < 8; ++i)
                a += (bflo(v[i].x) - bfhi(v[i].x)) + (bflo(v[i].y) - bfhi(v[i].y)) + (bflo(v[i].z) - bfhi(v[i].z)) + (bflo(v[i].w) - bfhi(v[i].w));
              a = wave_sum(a) * (1.f / 64.f);
              if (lane_ == 0) {
                const size_t row = (size_t)lu * 4096 + 2048;
                Z[row * ZS + Z_A + ch] = f2bf(a * silu(bf2f(proj[row * PS + C_GA + ch])));
              }
            }
          } else if (it < e4) {
            s5_item(p, layer, rd, it - e3, 2, smem);
          } else if (it < e5) {
            const int i2 = it - e4, seq = i2 >> 3, r = i2 & 7;
            attn_item(p, 0, 0, seq, r, 0, smem);
          } else {
            const int i2 = it - e5;
            for (int q = 0; q < 2; ++q) {
              const int tix = i2 * 4 + q * 2 + (int)(otid() >> 8), seq = tix >> 3, r = tix & 7, mt = r & 1, nt = r >> 1;
              f32x4 acc[4][4];
              ACC_ZERO(acc);
              gemm_tile(DftS + (size_t)mt * 128 * 512, 512, PQt + (size_t)seq * 512 * 512 + (size_t)nt * 128 * 512, 512, 512, acc, smem + (otid() >> 8) * 20480);
              EPI_IDX;
#pragma unroll
              for (int ni = 0; ni < 4; ++ni)
#pragma unroll
                for (int mi = 0; mi < 4; ++mi) {
                  const size_t row = (size_t)seq * 256 + mt * 128 + EPI_ROW(mi);
                  const int col = nt * 128 + EPI_COL(ni);
                  const uint2 gg = *(const uint2*)(proj + row * PS + C_GA + col);
                  const f32x4 a = acc[ni][mi];
                  *(uint2*)(Z + row * ZS + Z_A + col) = uint2{pack2(a[0] * silu(bflo(gg.x)), a[1] * silu(bfhi(gg.x))),
                                                               pack2(a[2] * silu(bflo(gg.y)), a[3] * silu(bfhi(gg.y)))};
                }
            }
          }
        }
      }
      xcd_barrier(xb);
      {
      PHASE_IDS;
      for (int row = gwave; row < RR; row += nwaves) {
        const u16* pr = proj + (size_t)row * PS;
        {
          const int c0 = lane * 8;
          const uint4 ya_ = *(const uint4*)(ys + (size_t)row * 512 + c0), yb_ = *(const uint4*)(ys + (size_t)(RR + row) * 512 + c0);
          const float4 a0 = float4{bflo(ya_.x), bfhi(ya_.x), bflo(ya_.y), bfhi(ya_.y)}, a1 = float4{bflo(ya_.z), bfhi(ya_.z), bflo(ya_.w), bfhi(ya_.w)};
          const float4 b0 = float4{bflo(yb_.x), bfhi(yb_.x), bflo(yb_.y), bfhi(yb_.y)}, b1 = float4{bflo(yb_.z), bfhi(yb_.z), bflo(yb_.w), bfhi(yb_.w)};
          const float4 d0 = *(const float4*)(p.in[22] + (size_t)layer * 512 + c0), d1 = *(const float4*)(p.in[22] + (size_t)layer * 512 + c0 + 4);
          const uint4 uu = *(const uint4*)(pr + C_UB + c0);
          uint4 o;
          o.x = pack2(gelu_t(a0.x + b0.x + d0.x * bflo(uu.x)), gelu_t(a0.y + b0.y + d0.y * bfhi(uu.x)));
          o.y = pack2(gelu_t(a0.z + b0.z + d0.z * bflo(uu.y)), gelu_t(a0.w + b0.w + d0.w * bfhi(uu.y)));
          o.z = pack2(gelu_t(a1.x + b1.x + d1.x * bflo(uu.z)), gelu_t(a1.y + b1.y + d1.y * bfhi(uu.z)));
          o.w = pack2(gelu_t(a1.z + b1.z + d1.z * bflo(uu.w)), gelu_t(a1.w + b1.w + d1.w * bfhi(uu.w)));
          *(uint4*)(yb + (size_t)row * 512 + c0) = o;
        }
      }
      for (int it = bid; it < 384; it += nb) hgrnB2_item(p, layer, it >> 1, it & 1);
      }
      xcd_barrier(xb);
      for (int t2 = bid; t2 < 96 * 2; t2 += nb) {
        const int gi6 = (int)(otid() >> 8);
        const int t = t2 * 2 + gi6;
        const int mt = t % 96, nt = t / 96;
        f32x4 acc[4][4];
        ACC_ZERO(acc);
        gemm_tile(yb + (size_t)mt * 128 * 512, 512, GluT + (size_t)layer * 512 * 512 + (size_t)nt * 128 * 512, 512, 512, acc, smem + gi6 * 20480);
        EPI_IDX;
        float4 bbs[4]; uint2 yys[4][4], ggs[4][4];
#pragma unroll
        for (int ni = 0; ni < 4; ++ni) {
          bbs[ni] = *(const float4*)(p.in[24] + (size_t)layer * 512 + nt * 128 + EPI_COL(ni));
#pragma unroll
          for (int mi = 0; mi < 4; ++mi) {
            const size_t row = (size_t)mt * 128 + EPI_ROW(mi);
            const int col = nt * 128 + EPI_COL(ni);
            yys[ni][mi] = *(const uint2*)(yb + row * 512 + col);
            ggs[ni][mi] = *(const uint2*)(proj + row * PS + C_GB + col);
          }
        }
        __builtin_amdgcn_sched_barrier(0);
#pragma unroll
        for (int ni = 0; ni < 4; ++ni)
#pragma unroll
          for (int mi = 0; mi < 4; ++mi) {
            const size_t row = (size_t)mt * 128 + EPI_ROW(mi);
            const int col = nt * 128 + EPI_COL(ni);
            const float4 bb = bbs[ni];
            const uint2 yy = yys[ni][mi];
            const uint2 gg = ggs[ni][mi];
            const f32x4 a = acc[ni][mi];
            const float r0 = bflo(yy.x) * sigm(a[0] + bb.x) * silu(bflo(gg.x)), r1 = bfhi(yy.x) * sigm(a[1] + bb.y) * silu(bfhi(gg.x));
            const float r2 = bflo(yy.y) * sigm(a[2] + bb.z) * silu(bflo(gg.y)), r3 = bfhi(yy.y) * sigm(a[3] + bb.w) * silu(bfhi(gg.y));
            *(uint2*)(Z + row * ZS + Z_B + col) = uint2{pack2(r0, r1), pack2(r2, r3)};
          }
      }
      xcd_barrier(xb);
      {
        const int ntl = (48 * 16 - bid + nb - 1) / nb;
        f32x4 mix[4][4], acc[4][4];
        ACC_ZERO(mix);
        ACC_ZERO(acc);
        if (ntl > 0)
        gemm256_stream<128>(ntl * 4,
          [&](int s_, const u16*& A_, int& lda_, const u16*& B_, int& ldb_, int& nk_) {
            const int t = bid + (s_ >> 2) * nb, mt = t % 48, nt = t / 48, j = s_ & 3;
            const int Kj = (j == 2) ? 1024 : 512;
            const int zo = (j == 0) ? Z_A : (j == 1) ? Z_B : (j == 2) ? Z_C : Z_D;
            const u16* Wj = (j == 0) ? WpA : (j == 1) ? WpB : (j == 2) ? WpC : WpD;
            A_ = Z + (size_t)mt * 256 * ZS + zo; lda_ = ZS; B_ = Wj + (size_t)layer * 2048 * Kj + (size_t)nt * 128 * Kj; ldb_ = Kj; nk_ = Kj >> 6;
          },
          [&](int s_, f32x4 (&ac)[4][4]) {
            const int t = bid + (s_ >> 2) * nb, mt = t % 48, nt = t / 48, j = s_ & 3;
            EPI256(128);
            uint2 ggs[4][4];
#pragma unroll
            for (int m = 0; m < 4; ++m)
#pragma unroll
              for (int n = 0; n < 4; ++n)
                ggs[m][n] = *(const uint2*)(proj + ((size_t)mt * 256 + E256_ROW(m)) * PS + C_M + j * 2048 + nt * 128 + E256_COL(n));
            __builtin_amdgcn_sched_barrier(0);
#pragma unroll
            for (int m = 0; m < 4; ++m)
#pragma unroll
              for (int n = 0; n < 4; ++n) {
                const size_t row = (size_t)mt * 256 + E256_ROW(m);
                const int col = nt * 128 + E256_COL(n);
                const uint2 gg = ggs[m][n];
                mix[m][n][0] += bflo(gg.x) * ac[m][n][0];
                mix[m][n][1] += bfhi(gg.x) * ac[m][n][1];
                mix[m][n][2] += bflo(gg.y) * ac[m][n][2];
                mix[m][n][3] += bfhi(gg.y) * ac[m][n][3];
                if (j == 3) {
                  *(uint2*)(mixed + row * 2048 + col) = uint2{pack2(mix[m][n][0], mix[m][n][1]), pack2(mix[m][n][2], mix[m][n][3])};
                  mix[m][n] = f32x4{0.f, 0.f, 0.f, 0.f};
                }
              }
          }, acc, shm);
      }
      xcd_barrier(xb);
      {
        const int ntl = (48 * 16 - bid + nb - 1) / nb;
        f32x4 acc[4][4];
        ACC_ZERO(acc);
        if (ntl > 0)
        gemm256_stream<128>(ntl,
          [&](int s_, const u16*& A_, int& lda_, const u16*& B_, int& ldb_, int& nk_) {
            const int t = bid + s_ * nb, mt = t % 48, nt = t / 48;
            A_ = mixed + (size_t)mt * 256 * 2048; lda_ = 2048; B_ = WoutT + (size_t)layer * 2048 * 2048 + (size_t)nt * 128 * 2048; ldb_ = 2048; nk_ = 32;
          },
          [&](int s_, f32x4 (&ac)[4][4]) {
            const int t = bid + s_ * nb, mt = t % 48, nt = t / 48;
            EPI256(128);
#pragma unroll
            for (int m = 0; m < 4; ++m)
#pragma unroll
              for (int n = 0; n < 4; ++n) {
                const size_t row = (size_t)mt * 256 + E256_ROW(m);
                const int col = nt * 128 + E256_COL(n);
                *(uint2*)(outb + row * 2048 + col) = uint2{pack2(ac[m][n][0], ac[m][n][1]), pack2(ac[m][n][2], ac[m][n][3])};
              }
          }, acc, shm);
      }
      xcd_barrier(xb);
      {
      PHASE_IDS;
      for (int row = gwave; row < RR; row += nwaves) {
        const int lu = row >> 12, t = row & 4095, unit = rd * 3 + lu;
        const float4* x4 = (const float4*)x_in_row(p, layer, unit, t);
        float4* y4 = (float4*)y_out_row(p, unit, t);
        const float* md = modb + (size_t)(layer * 9 + unit) * 6144 + 4096;
        const uint2* o4 = (const uint2*)(outb + (size_t)row * 2048);
        float4 v[8];
        float ss = 0.f;
#pragma unroll
        for (int i = 0; i < 8; ++i) {
          const uint2 ov = o4[lane + i * 64];
          v[i] = float4{bflo(ov.x), bfhi(ov.x), bflo(ov.y), bfhi(ov.y)};
          ss += v[i].x * v[i].x + v[i].y * v[i].y + v[i].z * v[i].z + v[i].w * v[i].w;
        }
        ss = wave_sum(ss);
        const float inv = rsqrtf(ss * (1.f / 2048.f) + 1e-6f);
        float4 xvs[8];
#pragma unroll
        for (int i = 0; i < 8; ++i) xvs[i] = x4[lane + i * 64];
        __builtin_amdgcn_sched_barrier(0);
#pragma unroll
        for (int i = 0; i < 8; ++i) {
          const int col = (lane + i * 64) * 4;
          const float4 g = *(const float4*)(p.in[10] + (size_t)layer * 2048 + col);
          const float4 gt = *(const float4*)(md + col);
          const float4 xv = xvs[i];
          float4 y;
          y.x = xv.x + gt.x * (v[i].x * inv * g.x); y.y = xv.y + gt.y * (v[i].y * inv * g.y);
          y.z = xv.z + gt.z * (v[i].z * inv * g.z); y.w = xv.w + gt.w * (v[i].w * inv * g.w);
          y4[lane + i * 64] = y;
          v[i] = y;
        }
        if (layer == 0) {
          float s2 = 0.f;
#pragma unroll
          for (int i = 0; i < 8; ++i) s2 += v[i].x * v[i].x + v[i].y * v[i].y + v[i].z * v[i].z + v[i].w * v[i].w;
          s2 = wave_sum(s2);
          const float inv2 = rsqrtf(s2 * (1.f / 2048.f) + 1e-6f);
          const float* md1 = modb + (size_t)(9 + unit) * 6144;
#pragma unroll
          for (int i = 0; i < 8; ++i) {
            const int col = (lane + i * 64) * 4;
            const float4 g = *(const float4*)(p.in[9] + 2048 + col);
            const float4 sh = *(const float4*)(md1 + col), sc = *(const float4*)(md1 + 2048 + col);
            const float h0 = v[i].x * inv2 * g.x * (1.f + sc.x) + sh.x, h1 = v[i].y * inv2 * g.y * (1.f + sc.y) + sh.y;
            const float h2 = v[i].z * inv2 * g.z * (1.f + sc.z) + sh.z, h3 = v[i].w * inv2 * g.w * (1.f + sc.w) + sh.w;
            *(uint2*)(hbuf + (size_t)row * 2048 + col) = uint2{pack2(h0, h1), pack2(h2, h3)};
          }
        }
      }
      }
      xcd_barrier(xb);
    }
  }
}

extern "C" void kernel_launch(void* const* d_in, const int* in_sizes, int n_in,
                              void* d_out, int out_size, void* d_ws, size_t ws_size,
                              hipStream_t stream) {
  static int grid_blocks = 0;
  if (!grid_blocks) {
    int dev = 0, cus = 0, per_cu = 0;
    (void)hipGetDevice(&dev);
    (void)hipDeviceGetAttribute(&cus, hipDeviceAttributeMultiprocessorCount, dev);
    (void)hipOccupancyMaxActiveBlocksPerMultiprocessor(&per_cu, mega, 512, 0);
    if (per_cu > 1) per_cu = 1;
    if (per_cu < 1) per_cu = 1;
    grid_blocks = cus * per_cu;
  }
  if (ws_size < OFF_END) { fprintf(stderr, "workspace too small: %zu < %zu\n", ws_size, (size_t)OFF_END); return; }
  Params p{};
  for (int i = 0; i < 34; ++i) p.in[i] = (const float*)d_in[i];
  p.out = (float*)d_out;
  p.ws = (char*)d_ws;
  void* args[] = {&p};
  hipError_t e = hipLaunchCooperativeKernel((void*)mega, dim3(grid_blocks), dim3(512), args, 0, stream);
  if (e != hipSuccess) fprintf(stderr, "cooperative launch failed: %s (grid %d)\n", hipGetErrorString(e), grid_blocks);
}
```

```cpp
#include <hip/hip_runtime.h>
#include <hip/hip_cooperative_groups.h>
#include <cstdio>
namespace cg = cooperative_groups;

typedef unsigned short u16;
using bf16x8 = __attribute__((ext_vector_type(8))) short;
using f32x4 = __attribute__((ext_vector_type(4))) float;
using u32x4 = __attribute__((ext_vector_type(4))) unsigned;

struct Params { const float* in[34]; float* out; char* ws; };

constexpr int DM = 2048;
constexpr int PS = 15360;
constexpr int C_UA = 0, C_GA = 512, C_UB = 1024, C_GB = 1536, C_QC = 2048, C_KC = 3072, C_VC = 3328, C_GC = 3584,
              C_QD = 4608, C_ID = 5120, C_ZF = 5632, C_ZB = 6144, C_GD = 6656, C_M = 7168;
constexpr int ZS = 2560;
constexpr int Z_A = 0, Z_B = 512, Z_C = 1024, Z_D = 2048;
constexpr int RR = 12288;
constexpr int NKMAX = 4608;

constexpr size_t OY_S = 8388608, OCK = 75497472, OCV = 77594624, OS5R = 79691776, OS5I = 79822848, OHG = 79953920;

constexpr size_t OFF_WINT = 0;
constexpr size_t OFF_WPA = OFF_WINT + (size_t)2 * 15360 * 2048 * 2;
constexpr size_t OFF_WPB = OFF_WPA + (size_t)2 * 2048 * 512 * 2;
constexpr size_t OFF_WPC = OFF_WPB + (size_t)2 * 2048 * 512 * 2;
constexpr size_t OFF_WPD = OFF_WPC + (size_t)2 * 2048 * 1024 * 2;
constexpr size_t OFF_WOUT = OFF_WPD + (size_t)2 * 2048 * 512 * 2;
constexpr size_t OFF_GLU = OFF_WOUT + (size_t)2 * 2048 * 2048 * 2;
constexpr size_t OFF_FWT = OFF_GLU + (size_t)2 * 512 * 512 * 2;
constexpr size_t OFF_DFTL = OFF_FWT + (size_t)2 * 4 * 256 * 128 * 2;
constexpr size_t OFF_DFTS = OFF_DFTL + (size_t)4096 * 8192 * 2;
constexpr size_t OFF_MODP = OFF_DFTS + (size_t)256 * 512 * 2;
constexpr size_t OFF_MOD = OFF_MODP + (size_t)16 * 2 * 9 * 6144 * 4;
constexpr size_t OFF_CTR = OFF_MOD + (size_t)2 * 9 * 6144 * 4;
constexpr size_t OFF_H = OFF_CTR + 4096;
constexpr size_t OFF_PROJ = OFF_H + (size_t)RR * 2048 * 2;
constexpr size_t OFF_Z = OFF_PROJ + (size_t)RR * PS * 2;
constexpr size_t OFF_PQT = OFF_Z + (size_t)RR * ZS * 2;
constexpr size_t OFF_YS = OFF_PQT + (size_t)RR * 1024 * 2;
constexpr size_t OFF_YB = OFF_YS + (size_t)2 * RR * 512 * 4;
constexpr size_t OFF_QB = OFF_YB + (size_t)RR * 512 * 2;
constexpr size_t OFF_KB = OFF_QB + (size_t)RR * 1024 * 2;
constexpr size_t OFF_VT = OFF_KB + (size_t)3 * NKMAX * 256 * 2;
constexpr size_t OFF_OHG = OFF_VT + (size_t)3 * 256 * NKMAX * 2;
constexpr size_t OFF_S5LOC = OFF_OHG + (size_t)2 * RR * 512 * 4;
constexpr size_t OFF_MIXED = OFF_S5LOC + (size_t)3072 * 128 * 4;
constexpr size_t OFF_QIB = OFF_MIXED + (size_t)RR * 2048 * 2;
constexpr size_t OFF_DS = OFF_QIB + (size_t)2 * RR * 512 * 2;
constexpr size_t OFF_DEC = OFF_DS + (size_t)2 * 192 * 4 * 128 * 128 * 2;
constexpr size_t OFF_XBAR = OFF_DEC + (size_t)2 * 192 * 4 * 128 * 4;
constexpr size_t OFF_END = OFF_XBAR + 16384;
constexpr size_t OFF_OUTB = OFF_PROJ;

__device__ __forceinline__ float bf2f(u16 h) { return __uint_as_float(((unsigned)h) << 16); }
__device__ __forceinline__ float bflo(unsigned w) { return __uint_as_float(w << 16); }
__device__ __forceinline__ float bfhi(unsigned w) { return __uint_as_float(w & 0xffff0000u); }
typedef float f32x2_t __attribute__((ext_vector_type(2)));
typedef __bf16 bf16x2_t __attribute__((ext_vector_type(2)));
__device__ __forceinline__ unsigned pack2(float a, float b) {
  f32x2_t v = {a, b};
  bf16x2_t r = __builtin_convertvector(v, bf16x2_t);
  return __builtin_bit_cast(unsigned, r);
}
__device__ __forceinline__ u16 f2bf(float f) { return (u16)(pack2(f, f) & 0xffffu); }
__device__ __forceinline__ float sigm(float x) { return __builtin_amdgcn_rcpf(1.f + __expf(-x)); }
__device__ __forceinline__ float silu(float x) { return x * __builtin_amdgcn_rcpf(1.f + __expf(-x)); }
__device__ __forceinline__ float gelu_t(float x) {
  float u = 0.7978845608028654f * (x + 0.044715f * x * x * x);
  float t = 1.f - 2.f * __builtin_amdgcn_rcpf(1.f + __expf(2.f * u));
  return 0.5f * x * (1.f + t);
}
__device__ __forceinline__ float rowmax4(float x) {
  auto r = __builtin_amdgcn_permlane16_swap(__float_as_uint(x), __float_as_uint(x), false, false);
  const float m = fmaxf(__uint_as_float(r[0]), __uint_as_float(r[1]));
  auto q = __builtin_amdgcn_permlane32_swap(__float_as_uint(m), __float_as_uint(m), false, false);
  return fmaxf(__uint_as_float(q[0]), __uint_as_float(q[1]));
}
__device__ __forceinline__ float rowsum4(float x) {
  auto r = __builtin_amdgcn_permlane16_swap(__float_as_uint(x), __float_as_uint(x), false, false);
  const float m = __uint_as_float(r[0]) + __uint_as_float(r[1]);
  auto q = __builtin_amdgcn_permlane32_swap(__float_as_uint(m), __float_as_uint(m), false, false);
  return __uint_as_float(q[0]) + __uint_as_float(q[1]);
}
__device__ __forceinline__ float dpp_add(float v, const int ctrl_sel) {
  const int x = __float_as_int(v);
  int y;
  if (ctrl_sel == 0) y = __builtin_amdgcn_update_dpp(x, x, 0xB1, 0xF, 0xF, false);
  else if (ctrl_sel == 1) y = __builtin_amdgcn_update_dpp(x, x, 0x4E, 0xF, 0xF, false);
  else if (ctrl_sel == 2) y = __builtin_amdgcn_update_dpp(x, x, 0x141, 0xF, 0xF, false);
  else y = __builtin_amdgcn_update_dpp(x, x, 0x140, 0xF, 0xF, false);
  return v + __int_as_float(y);
}
__device__ __forceinline__ float wave_sum(float v) {
  v = dpp_add(v, 0); v = dpp_add(v, 1); v = dpp_add(v, 2); v = dpp_add(v, 3);
  return rowsum4(v);
}
__device__ __forceinline__ int grab(int* ctr, int* slot) {
  __syncthreads();
  if (threadIdx.x == 0) *slot = atomicAdd(ctr, 1);
  __syncthreads();
  return *slot;
}

__device__ __forceinline__ int otid() { int t = threadIdx.x; asm volatile("" : "+v"(t)); return t; }
#define XB_TMO      128
#define XB_XCNT(j)  (256  + 64 * (j))
#define XB_XSUB(j)  (1280 + 64 * (j))
#define XB_XGEN(j)  (2304 + 64 * (j))
#define XB_TOP      3328
#define XB_TOPGEN   3392
#define XCD_BAR_WORDS 3456
#define XB_SPIN_CAP (1u << 18)
#define LAS __attribute__((address_space(3)))

__device__ __forceinline__ unsigned xb_ld(unsigned* p)              { return __hip_atomic_load(p, __ATOMIC_RELAXED, __HIP_MEMORY_SCOPE_AGENT); }
__device__ __forceinline__ unsigned xb_add(unsigned* p, unsigned v) { return __hip_atomic_fetch_add(p, v, __ATOMIC_RELAXED, __HIP_MEMORY_SCOPE_AGENT); }
__device__ __forceinline__ unsigned xb_xcc_id() { return (unsigned)__builtin_amdgcn_s_getreg((3 << 11) | 20) & 0xFu; }
#define XB_SPIN(cond, bar) do { unsigned _sp = 0; while (cond) { __builtin_amdgcn_s_sleep(1); \
    if ((++_sp & 255u) == 0u) { if (xb_ld(&(bar)[XB_TMO])) break; if (_sp > XB_SPIN_CAP) { atomicAdd(&(bar)[XB_TMO], 1u); break; } } } } while (0)

struct XcdBarrier {
    unsigned* bar; unsigned x;
    volatile LAS unsigned* st;
};

__device__ __forceinline__ XcdBarrier xcd_barrier_post(unsigned* bar, volatile LAS unsigned* st) {
    XcdBarrier b; b.bar = bar; b.x = xb_xcc_id(); b.st = st;
    if (threadIdx.x == 0) (void)xb_add(&bar[XB_XCNT(b.x)], 1u);
    return b;
}
__device__ __forceinline__ void xcd_barrier_complete(unsigned* bar, unsigned x, unsigned& nloc, unsigned& nx) {
    const unsigned G = gridDim.x * gridDim.y * gridDim.z;
    unsigned sum, cnt, mine, sp = 0u;
    for (;;) {
        sum = 0u; cnt = 0u; mine = 0u;
#pragma unroll
        for (unsigned j = 0; j < 16; ++j) { const unsigned c = xb_ld(&bar[XB_XCNT(j)]); sum += c; cnt += (c > 0u) ? 1u : 0u; mine = (j == x) ? c : mine; }
        if (sum == G) break;
        __builtin_amdgcn_s_sleep(1);
        if ((++sp & 255u) == 0u) { if (xb_ld(&bar[XB_TMO])) break; if (sp > XB_SPIN_CAP) { atomicAdd(&bar[XB_TMO], 1u); break; } }
    }
    nloc = mine > 0u ? mine : 1u; nx = cnt > 0u ? cnt : 1u;
}

__device__ __forceinline__ void xcd_barrier(const XcdBarrier& b) {
    asm volatile("s_waitcnt vmcnt(0)" ::: "memory");
    __syncthreads();
    if (threadIdx.x == 0) {
        unsigned* bar = b.bar;
        __builtin_amdgcn_s_waitcnt(0);
        unsigned nloc = b.st[0], nx = b.st[1];
        if (nloc == 0u) { xcd_barrier_complete(bar, b.x, nloc, nx); b.st[0] = nloc; b.st[1] = nx; }
        const unsigned old = xb_add(&bar[XB_XSUB(b.x)], 1u);
        const unsigned gen = old / nloc;
        if (old + 1u == (gen + 1u) * nloc) {
            __builtin_amdgcn_fence(__ATOMIC_RELEASE, "agent");
            asm volatile("s_waitcnt vmcnt(0)" ::: "memory");
            const unsigned og = xb_add(&bar[XB_TOP], 1u);
            const unsigned tg = og / nx;
            if (og + 1u == (tg + 1u) * nx) xb_add(&bar[XB_TOPGEN], 1u);
            else XB_SPIN(xb_ld(&bar[XB_TOPGEN]) == tg, bar);
            __builtin_amdgcn_fence(__ATOMIC_ACQUIRE, "agent");
            xb_add(&bar[XB_XGEN(b.x)], 1u);
            asm volatile("s_waitcnt vmcnt(0)" ::: "memory");
        } else {
            XB_SPIN(xb_ld(&bar[XB_XGEN(b.x)]) == gen, bar);
            __builtin_amdgcn_fence(__ATOMIC_ACQUIRE, "agent");
            asm volatile("s_waitcnt vmcnt(0)" ::: "memory");
        }
    }
    __syncthreads();
}

__device__ __forceinline__ void gbar(unsigned* cnt, unsigned& target) {
  asm volatile("s_waitcnt vmcnt(0)" ::: "memory");
  __syncthreads();
  target += gridDim.x;
  if (threadIdx.x == 0) {
    __builtin_amdgcn_fence(__ATOMIC_RELEASE, "agent");
    asm volatile("s_waitcnt vmcnt(0)" ::: "memory");
    __hip_atomic_fetch_add(cnt, 1u, __ATOMIC_RELAXED, __HIP_MEMORY_SCOPE_AGENT);
    while (__hip_atomic_load(cnt, __ATOMIC_RELAXED, __HIP_MEMORY_SCOPE_AGENT) < target) __builtin_amdgcn_s_sleep(1);
    __builtin_amdgcn_fence(__ATOMIC_ACQUIRE, "agent");
    asm volatile("s_waitcnt vmcnt(0)" ::: "memory");
  }
  __syncthreads();
}
__device__ __forceinline__ const float* x_in_row(const Params& p, int layer, int unit, int t) {
  size_t off = (unit == 0) ? (size_t)t * DM : (size_t)((unit - 1) * 4096 + t) * DM;
  if (layer == 0) return ((unit == 0) ? p.in[0] : p.in[1]) + off;
  return p.out + ((unit == 0) ? 0 : OY_S) + off;
}
__device__ __forceinline__ float* y_out_row(const Params& p, int unit, int t) {
  size_t off = (unit == 0) ? (size_t)t * DM : (size_t)((unit - 1) * 4096 + t) * DM;
  return p.out + ((unit == 0) ? 0 : OY_S) + off;
}

constexpr int LDT = 40;
__device__ __forceinline__ void gemm_tile(const u16* __restrict__ A, size_t lda, const u16* __restrict__ B, size_t ldb,
                                          int K, f32x4 (&acc)[4][4], u16* sm) {
  const int tid = otid() & 255, lane = tid & 63, wid = tid >> 6, wr = wid >> 1, wc = wid & 1, fr = lane & 15, fq = lane >> 4;
  u16* As = sm;
  u16* Bs = sm + 2 * 128 * LDT;
  const int lrow = tid >> 2, lkc = (tid & 3) * 8;
  const u16* Ag = A + (size_t)lrow * lda + lkc;
  const u16* Bg = B + (size_t)lrow * ldb + lkc;
  const size_t a64 = 64 * lda, b64 = 64 * ldb;
  uint4 ra0 = *(const uint4*)(Ag), ra1 = *(const uint4*)(Ag + a64);
  uint4 rb0 = *(const uint4*)(Bg), rb1 = *(const uint4*)(Bg + b64);
  __syncthreads();
  *(uint4*)(As + lrow * LDT + lkc) = ra0;
  *(uint4*)(As + (lrow + 64) * LDT + lkc) = ra1;
  *(uint4*)(Bs + lrow * LDT + lkc) = rb0;
  *(uint4*)(Bs + (lrow + 64) * LDT + lkc) = rb1;
  __syncthreads();
  const int nk = K >> 5;
  for (int kt = 0; kt < nk; ++kt) {
    const int cur = kt & 1;
    const bool more = (kt + 1 < nk);
    if (more) {
      const int ko = (kt + 1) * 32;
      ra0 = *(const uint4*)(Ag + ko); ra1 = *(const uint4*)(Ag + a64 + ko);
      rb0 = *(const uint4*)(Bg + ko); rb1 = *(const uint4*)(Bg + b64 + ko);
    }
    const u16* as = As + cur * 128 * LDT;
    const u16* bs = Bs + cur * 128 * LDT;
    bf16x8 af[4], bfg[4];
#pragma unroll
    for (int i = 0; i < 4; ++i) {
      af[i] = *(const bf16x8*)(as + (wr * 64 + i * 16 + fr) * LDT + fq * 8);
      bfg[i] = *(const bf16x8*)(bs + (wc * 64 + i * 16 + fr) * LDT + fq * 8);
    }
#pragma unroll
    for (int ni = 0; ni < 4; ++ni)
#pragma unroll
      for (int mi = 0; mi < 4; ++mi)
        acc[ni][mi] = __builtin_amdgcn_mfma_f32_16x16x32_bf16(bfg[ni], af[mi], acc[ni][mi], 0, 0, 0);
    if (more) {
      u16* aw = As + (cur ^ 1) * 128 * LDT;
      u16* bw = Bs + (cur ^ 1) * 128 * LDT;
      *(uint4*)(aw + lrow * LDT + lkc) = ra0;
      *(uint4*)(aw + (lrow + 64) * LDT + lkc) = ra1;
      *(uint4*)(bw + lrow * LDT + lkc) = rb0;
      *(uint4*)(bw + (lrow + 64) * LDT + lkc) = rb1;
    }
    __syncthreads();
  }
}
#define ACC_ZERO(acc) _Pragma("unroll") for (int _a = 0; _a < 4; ++_a) _Pragma("unroll") for (int _b = 0; _b < 4; ++_b) acc[_a][_b] = f32x4{0.f, 0.f, 0.f, 0.f}
#define EPI_IDX const int tid_ = otid() & 255, lane_ = tid_ & 63, wid_ = tid_ >> 6, wr_ = wid_ >> 1, wc_ = wid_ & 1, fr_ = lane_ & 15, fq_ = lane_ >> 4
#define EPI_ROW(mi) (wr_ * 64 + (mi) * 16 + fr_)
#define EPI_COL(ni) (wc_ * 64 + (ni) * 16 + fq_ * 4)


__device__ __forceinline__ int lds_byte2(int r, int c) {
  int st = (r >> 4) * 2 + (c >> 5), ob = (r & 15) * 64 + (c & 31) * 2;
  return st * 1024 + (ob ^ (((ob >> 9) & 1) << 5));
}
__device__ __forceinline__ void stage_rc2(int b, int& R, int& C) {
  int st = b >> 10, sb = b & 1023, swz = sb ^ (((sb >> 9) & 1) << 5);
  R = (st >> 1) * 16 + swz / 64;
  C = (st & 1) * 32 + (swz % 64) / 2;
}
using i32x4 = __attribute__((ext_vector_type(4))) int;
template <int BN>
__device__ __forceinline__ void gemm256(const u16* __restrict__ A, int lda, const u16* __restrict__ B, int ldb, int K,
                                        f32x4 (&acc)[(BN == 256) ? 8 : 4][4], char* shm) {
  constexpr int MT = (BN == 256) ? 8 : 4, WM = MT * 16;
  constexpr int TA = 256 * 64 * 2, TB = BN * 64 * 2, STAGE = TA + TB;
  constexpr int GLA = 4, GLB = TB / 8192;
  const int tid = otid(), wid = tid >> 6, lane = tid & 63, fr = lane & 15, fq = lane >> 4;
  const int wr = (BN == 256) ? (wid >> 2) : (wid >> 1), wc = (BN == 256) ? (wid & 3) : (wid & 1);
  int oa[GLA], ob[GLB];
#pragma unroll
  for (int i = 0; i < GLA; ++i) { int R, C; stage_rc2(wid * 1024 + i * 8192 + lane * 16, R, C); oa[i] = R * lda + C; }
#pragma unroll
  for (int i = 0; i < GLB; ++i) { int R, C; stage_rc2(wid * 1024 + i * 8192 + lane * 16, R, C); ob[i] = R * ldb + C; }
  i32x4 sa[GLA], sb[GLB];
  char* wbase = shm + wid * 1024 + lane * 16;
#define G_ISSUE(kt) do { _Pragma("unroll") for (int i = 0; i < GLA; ++i) sa[i] = *(const i32x4*)(A + oa[i] + (kt) * 64); \
                         _Pragma("unroll") for (int i = 0; i < GLB; ++i) sb[i] = *(const i32x4*)(B + ob[i] + (kt) * 64); } while (0)
#define G_WRITE(buf) do { _Pragma("unroll") for (int i = 0; i < GLA; ++i) *(i32x4*)(wbase + (buf) * STAGE + i * 8192) = sa[i]; \
                          _Pragma("unroll") for (int i = 0; i < GLB; ++i) *(i32x4*)(wbase + (buf) * STAGE + TA + i * 8192) = sb[i]; } while (0)
  const int nt = K >> 6;
  G_ISSUE(0);
  __syncthreads();
  G_WRITE(0);
  G_ISSUE(1);
  __syncthreads();
  for (int t = 0; t < nt; ++t) {
    const int cur = t & 1;
    if (t + 1 < nt) G_WRITE(cur ^ 1);
    if (t + 2 < nt) G_ISSUE(t + 2);
    const char* sA = shm + cur * STAGE;
    const char* sB = sA + TA;
#pragma unroll
    for (int ks = 0; ks < 2; ++ks) {
      bf16x8 At[MT], Bf[4];
#pragma unroll
      for (int m = 0; m < MT; ++m) At[m] = *(const bf16x8*)(sA + lds_byte2(wr * WM + m * 16 + fr, ks * 32 + fq * 8));
#pragma unroll
      for (int n = 0; n < 4; ++n) Bf[n] = *(const bf16x8*)(sB + lds_byte2(wc * 64 + n * 16 + fr, ks * 32 + fq * 8));
#pragma unroll
      for (int m = 0; m < MT; ++m)
#pragma unroll
        for (int n = 0; n < 4; ++n) acc[m][n] = __builtin_amdgcn_mfma_f32_16x16x32_bf16(Bf[n], At[m], acc[m][n], 0, 0, 0);
    }
    __syncthreads();
  }
#undef G_ISSUE
#undef G_WRITE
}

template <int BN, class SegFn, class EndFn>
__device__ __forceinline__ void gemm256_stream(int nseg, SegFn seg, EndFn endf, f32x4 (&acc)[(BN == 256) ? 8 : 4][4], char* shm) {
  constexpr int MT = (BN == 256) ? 8 : 4, WM = MT * 16;
  constexpr int TA = 256 * 64 * 2, TB = BN * 64 * 2, STAGE = 65536;
  constexpr int GLA = 4, GLB = TB / 8192;
  const int tid = otid(), wid = tid >> 6, lane = tid & 63, fr = lane & 15, fq = lane >> 4;
  const int wr = (BN == 256) ? (wid >> 2) : (wid >> 1), wc = (BN == 256) ? (wid & 3) : (wid & 1);
  int total = 0;
  for (int s_ = 0; s_ < nseg; ++s_) { const u16 *a_, *b_; int la_, lb_, nk_; seg(s_, a_, la_, b_, lb_, nk_); total += nk_; }
  int ps = 0, pk = 0, pnk, plda, pldb;
  const u16 *pA, *pB;
  seg(0, pA, plda, pB, pldb, pnk);
  unsigned oa[GLA], ob[GLB];
#define S_OFFS() do { _Pragma("unroll") for (int i = 0; i < GLA; ++i) { int R_, C_; stage_rc2(wid * 1024 + i * 8192 + lane * 16, R_, C_); \
      oa[i] = (unsigned)(R_ * plda + C_) * 2u; if (i < GLB) ob[i] = (unsigned)(R_ * pldb + C_) * 2u; } } while (0)
  S_OFFS();
  int cs = 0, ck = 0, cnk = pnk;
  char* wbase = shm + (wid & 7) * 1024;
#define S_STAGE(buf) do { \
    const char* ak_ = (const char*)pA + pk * 128; \
    const char* bk_ = (const char*)pB + pk * 128; \
    _Pragma("unroll") for (int i = 0; i < GLA; ++i) \
      __builtin_amdgcn_global_load_lds((const unsigned*)(ak_ + oa[i]), (unsigned*)(wbase + (buf) * STAGE + i * 8192), 16, 0, 0); \
    _Pragma("unroll") for (int i = 0; i < GLB; ++i) \
      __builtin_amdgcn_global_load_lds((const unsigned*)(bk_ + ob[i]), (unsigned*)(wbase + (buf) * STAGE + TA + i * 8192), 16, 0, 0); \
    if (++pk == pnk) { pk = 0; if (++ps < nseg) { seg(ps, pA, plda, pB, pldb, pnk); S_OFFS(); } } } while (0)
  __syncthreads();
  S_STAGE(0);
  asm volatile("s_waitcnt vmcnt(0)" ::: "memory");
  __syncthreads();
#define S_BODY(cur) do { \
    if (g + 1 < total) S_STAGE((cur) ^ 1); \
    const char* sA = shm + (cur) * STAGE; \
    const char* sB = sA + TA; \
    _Pragma("unroll") for (int ks = 0; ks < 2; ++ks) { \
      bf16x8 At[MT], Bf[4]; \
      _Pragma("unroll") for (int m = 0; m < MT; ++m) At[m] = *(const bf16x8*)(sA + (lds_byte2(wr * WM + m * 16 + fr, ks * 32 + fq * 8) & 0x7FFF)); \
      _Pragma("unroll") for (int n = 0; n < 4; ++n) Bf[n] = *(const bf16x8*)(sB + (lds_byte2(wc * 64 + n * 16 + fr, ks * 32 + fq * 8) & 0x7FFF)); \
      _Pragma("unroll") for (int m = 0; m < MT; ++m) \
        _Pragma("unroll") for (int n = 0; n < 4; ++n) acc[m][n] = __builtin_amdgcn_mfma_f32_16x16x32_bf16(Bf[n], At[m], acc[m][n], 0, 0, 0); \
      __builtin_amdgcn_sched_group_barrier(0x100, 6, 0); \
      _Pragma("unroll") for (int m = 0; m < MT; ++m) { \
        __builtin_amdgcn_sched_group_barrier(0x008, 4, 0); \
        if (m + 2 < MT) __builtin_amdgcn_sched_group_barrier(0x100, 1, 0); \
      } \
    } \
    if (++ck == cnk) { \
      endf(cs, acc); \
      _Pragma("unroll") for (int m = 0; m < MT; ++m) \
        _Pragma("unroll") for (int n = 0; n < 4; ++n) acc[m][n] = f32x4{0.f, 0.f, 0.f, 0.f}; \
      ck = 0; \
      if (++cs < nseg) { const u16 *a_, *b_; int la_, lb_; seg(cs, a_, la_, b_, lb_, cnk); } \
    } \
    asm volatile("s_waitcnt vmcnt(0)" ::: "memory"); \
    __syncthreads(); \
    ++g; } while (0)
  for (int g = 0; g < total;) {
    S_BODY(0);
    if (g < total) S_BODY(1);
  }
#undef S_BODY
#undef S_STAGE
#undef S_OFFS
}

#define EPI256(BN_) const int tid_ = otid(), wid_ = tid_ >> 6, lane_ = tid_ & 63, fr_ = lane_ & 15, fq_ = lane_ >> 4, \
    wr_ = ((BN_) == 256) ? (wid_ >> 2) : (wid_ >> 1), wc_ = ((BN_) == 256) ? (wid_ & 3) : (wid_ & 1), wm_ = ((BN_) == 256) ? 128 : 64
#define E256_ROW(m) (wr_ * wm_ + (m) * 16 + fr_)
#define E256_COL(n) (wc_ * 64 + (n) * 16 + fq_ * 4)

__device__ __forceinline__ void conv_transpose(const float* __restrict__ src, int K, int N, u16* __restrict__ dst, float* tile) {
  const int tid = otid(), lane = tid & 63, w = tid >> 6;
  const int ntn = N >> 8, nt = (K >> 6) * ntn;
  for (int t = blockIdx.x; t < nt; t += gridDim.x) {
    const int k0 = (t / ntn) << 6, n0 = (t % ntn) << 8;
    const float* sp = src + (size_t)(k0 + w * 8) * N + n0 + lane * 4;
    const float4 v0 = *(const float4*)(sp), v1 = *(const float4*)(sp + (size_t)N), v2 = *(const float4*)(sp + (size_t)2 * N), v3 = *(const float4*)(sp + (size_t)3 * N);
    const float4 v4 = *(const float4*)(sp + (size_t)4 * N), v5 = *(const float4*)(sp + (size_t)5 * N), v6 = *(const float4*)(sp + (size_t)6 * N), v7 = *(const float4*)(sp + (size_t)7 * N);
    __syncthreads();
    float* tw = tile + (w * 8) * 260 + lane * 4;
    *(float4*)(tw) = v0; *(float4*)(tw + 260) = v1; *(float4*)(tw + 520) = v2; *(float4*)(tw + 780) = v3;
    *(float4*)(tw + 1040) = v4; *(float4*)(tw + 1300) = v5; *(float4*)(tw + 1560) = v6; *(float4*)(tw + 1820) = v7;
    __syncthreads();
    const int kg = tid & 7;
#pragma unroll
    for (int i = 0; i < 4; ++i) {
      const int n = (tid >> 3) + i * 64;
      const float* tp = tile + (kg * 8) * 260 + n;
      uint4 o;
      o.x = pack2(tp[0], tp[260]); o.y = pack2(tp[2 * 260], tp[3 * 260]);
      o.z = pack2(tp[4 * 260], tp[5 * 260]); o.w = pack2(tp[6 * 260], tp[7 * 260]);
      *(uint4*)(dst + (size_t)(n0 + n) * K + k0 + kg * 8) = o;
    }
  }
}

__device__ __forceinline__ void s5_item(const Params& p, int layer, int rd, int bi, int pass, u16* smem) {
  const int tid = otid(), lane = tid & 63, wid = tid >> 6, fr = lane & 15, fq = lane >> 4;
  const int w = bi * 8 + wid;
  const int lu = w >> 10, rem = w & 1023, d = rem & 1, g = (rem >> 1) & 31, ss = rem >> 6;
  const int unit = rd * 3 + lu;
  const bool ctx = (unit == 0);
  const int L = ctx ? 256 : 4096;
  const int seq = ctx ? ss : 0, seg = ctx ? 0 : ss;
  const int rowbase = lu * 4096 + seq * L;
  const u16* proj = (const u16*)(p.ws + OFF_PROJ);
  float* bul = (float*)smem + wid * 2560;
  u16* Hs = smem + 40960 + wid * (16 * 136);
  const int pg = ((layer * 2 + d) * 32 + g);
  const float step = __expf(p.in[17][pg]);
  float lbr, lbi;
  {
    const float lre = p.in[15][pg * 64 + lane], lim = p.in[16][pg * 64 + lane];
    const float mag = __expf(lre * step);
    lbr = mag * __cosf(lim * step); lbi = mag * __sinf(lim * step);
  }
  bf16x8 bbf[8], bbl[8];
#pragma unroll
  for (int q = 0; q < 4; ++q) {
    const int n = q * 16 + fr;
    const float lre = p.in[15][pg * 64 + n], lim = p.in[16][pg * 64 + n];
    const float mag = __expf(lre * step);
    const float br_ = mag * __cosf(lim * step), bi_ = mag * __sinf(lim * step);
    const float nr = br_ - 1.f, den = lre * lre + lim * lim;
    const float fre = (nr * lre + bi_ * lim) / den, fim = (bi_ * lre - nr * lim) / den;
    const float* br = p.in[18] + ((size_t)pg * 64 + n) * 16 + (fq & 1) * 8;
    const float* bim = p.in[19] + ((size_t)pg * 64 + n) * 16 + (fq & 1) * 8;
    const float msk = (fq < 2) ? 1.f : 0.f;
    u32x4 ure, uim, lre_, lim_;
#pragma unroll
    for (int i = 0; i < 4; ++i) {
      const float a0 = br[2 * i] * msk, b0 = bim[2 * i] * msk, a1 = br[2 * i + 1] * msk, b1 = bim[2 * i + 1] * msk;
      const float r0 = fre * a0 - fim * b0, r1 = fre * a1 - fim * b1, m0 = fre * b0 + fim * a0, m1 = fre * b1 + fim * a1;
      ure[i] = pack2(r0, r1);
      uim[i] = pack2(m0, m1);
      lre_[i] = pack2(r0 - bflo(ure[i]), r1 - bfhi(ure[i]));
      lim_[i] = pack2(m0 - bflo(uim[i]), m1 - bfhi(uim[i]));
    }
    bbf[q] = __builtin_bit_cast(bf16x8, ure);
    bbf[4 + q] = __builtin_bit_cast(bf16x8, uim);
    bbl[q] = __builtin_bit_cast(bf16x8, lre_);
    bbl[4 + q] = __builtin_bit_cast(bf16x8, lim_);
  }
  float hr = 0.f, hi = 0.f;
  bf16x8 cf[4];
  u16* ysd = (u16*)(p.ws + OFF_YS) + (size_t)d * RR * 512;
  float* loc = (float*)(p.ws + OFF_S5LOC);
  if (pass == 2) {
    if (!ctx) {
      const size_t si = ((((size_t)(unit - 1) * 2 + layer) * 2 + d) * 32 + g) * 64 + lane;
      hr = p.in[5][si]; hi = p.in[6][si];
    }
    float ar = lbr, ai = lbi;
#pragma unroll
    for (int i = 0; i < 8; ++i) { float t = ar * ar - ai * ai; ai = 2.f * ar * ai; ar = t; }
    for (int i = 0; i < seg; ++i) {
      const int wi = (lu << 10) + (i << 6) + (g << 1) + d;
      const float lr_ = loc[(size_t)wi * 128 + lane], li_ = loc[(size_t)wi * 128 + 64 + lane];
      const float t = ar * hr - ai * hi + lr_;
      hi = ar * hi + ai * hr + li_;
      hr = t;
    }
    const float* cre = p.in[20] + ((size_t)pg * 16 + fr) * 64;
    const float* cim = p.in[21] + ((size_t)pg * 16 + fr) * 64;
#pragma unroll
    for (int ks = 0; ks < 4; ++ks) {
      const float* src = (ks < 2) ? (cre + ks * 32 + fq * 8) : (cim + (ks - 2) * 32 + fq * 8);
      const float sg = (ks < 2) ? 1.f : -1.f;
      u32x4 uc;
#pragma unroll
      for (int i = 0; i < 4; ++i) uc[i] = pack2(sg * src[2 * i], sg * src[2 * i + 1]);
      cf[ks] = __builtin_bit_cast(bf16x8, uc);
    }
  }
  auto load_u = [&](int sbg) -> u32x4 {
    const int pos = seg * 256 + sbg * 16 + fr;
    const int l = d ? (L - 1 - pos) : pos;
    u32x4 v = *(const u32x4*)(proj + (size_t)(rowbase + l) * PS + C_UB + g * 16 + (fq & 1) * 8);
    if (fq >= 2) v = u32x4{0u, 0u, 0u, 0u};
    return v;
  };
  u32x4 unext = load_u(0);
  for (int sbg = 0; sbg < 16; ++sbg) {
    const bf16x8 uf = __builtin_bit_cast(bf16x8, unext);
    if (sbg + 1 < 16) unext = load_u(sbg + 1);
#pragma unroll
    for (int nt = 0; nt < 8; ++nt) {
      f32x4 a = f32x4{0.f, 0.f, 0.f, 0.f};
      a = __builtin_amdgcn_mfma_f32_16x16x32_bf16(uf, bbl[nt], a, 0, 0, 0);
      a = __builtin_amdgcn_mfma_f32_16x16x32_bf16(uf, bbf[nt], a, 0, 0, 0);
      *(f32x4*)(bul + (nt * 16 + fr) * 20 + fq * 4) = a;
    }
    asm volatile("s_waitcnt lgkmcnt(0)" ::: "memory"); __builtin_amdgcn_wave_barrier();
    float bre[16], bim_[16];
#pragma unroll
    for (int k = 0; k < 4; ++k) {
      const f32x4 x = *(const f32x4*)(bul + lane * 20 + k * 4), y = *(const f32x4*)(bul + (64 + lane) * 20 + k * 4);
      bre[4 * k] = x[0]; bre[4 * k + 1] = x[1]; bre[4 * k + 2] = x[2]; bre[4 * k + 3] = x[3];
      bim_[4 * k] = y[0]; bim_[4 * k + 1] = y[1]; bim_[4 * k + 2] = y[2]; bim_[4 * k + 3] = y[3];
    }
    asm volatile("s_waitcnt lgkmcnt(0)" ::: "memory"); __builtin_amdgcn_wave_barrier();
#pragma unroll
    for (int s2 = 0; s2 < 16; ++s2) {
      const float t = lbr * hr - lbi * hi + bre[s2];
      hi = lbr * hi + lbi * hr + bim_[s2];
      hr = t;
      if (pass == 2) { Hs[s2 * 136 + lane] = f2bf(hr); Hs[s2 * 136 + 64 + lane] = f2bf(hi); }
    }
    if (pass == 2) {
      asm volatile("s_waitcnt lgkmcnt(0)" ::: "memory"); __builtin_amdgcn_wave_barrier();
      f32x4 ya = f32x4{0.f, 0.f, 0.f, 0.f};
#pragma unroll
      for (int ks = 0; ks < 4; ++ks) {
        const bf16x8 hf = *(const bf16x8*)(Hs + fr * 136 + ks * 32 + fq * 8);
        ya = __builtin_amdgcn_mfma_f32_16x16x32_bf16(hf, cf[ks], ya, 0, 0, 0);
      }
#pragma unroll
      for (int j = 0; j < 4; ++j) {
        const int pos = seg * 256 + sbg * 16 + fq * 4 + j;
        const int l = d ? (L - 1 - pos) : pos;
        ysd[(size_t)(rowbase + l) * 512 + g * 16 + fr] = f2bf(ya[j]);
      }
      asm volatile("s_waitcnt lgkmcnt(0)" ::: "memory"); __builtin_amdgcn_wave_barrier();
    }
  }
  if (pass == 1) {
    loc[(size_t)w * 128 + lane] = hr;
    loc[(size_t)w * 128 + 64 + lane] = hi;
  } else if (ctx) {
    const size_t oi = ((((size_t)seq * 2 + layer) * 2 + d) * 32 + g) * 64 + lane;
    p.out[OS5R + oi] = hr;
    p.out[OS5I + oi] = hi;
  }
}

__device__ __forceinline__ void hgrnA_item(const Params& p, int layer, int gc, int h, char* shm) {
  const int tid = otid(), lane = tid & 63, w = tid >> 6, fr = lane & 15, fq = lane >> 4;
  const int d = tid & 127, tq = tid >> 7;
  const u16* proj = (const u16*)(p.ws + OFF_PROJ);
  u16* Qm = (u16*)shm;
  u16* Km = (u16*)(shm + 17408);
  u16* KlT = (u16*)(shm + 34816);
  u16* VT = (u16*)(shm + 53248);
  u16* Pm = (u16*)(shm + 71680);
  float* tot = (float*)(shm + 80896);
  const int rowb = gc * 64;
  for (int dir = 0; dir < 2; ++dir) {
    float lb = 0.f;
    if (layer == 1) {
      const int ci = dir * 512 + h * 128 + d;
      const float l0 = p.in[27][ci], l1 = p.in[27][1024 + ci];
      lb = 1.f / (1.f + __expf(l0 - l1));
    }
    float cl[16], kk[16], qv[16];
    float c = 0.f;
    const int zc = (dir ? C_ZB : C_ZF) + h * 128 + d;
    u16 rz[16], rq[16], rvv[16];
#pragma unroll
    for (int i = 0; i < 16; ++i) {
      const int t = tq * 16 + i;
      const size_t ro = (size_t)(rowb + (dir ? 63 - t : t)) * PS;
      rz[i] = proj[ro + zc];
      rq[i] = proj[ro + C_QD + h * 128 + d];
      rvv[i] = proj[ro + C_ID + h * 128 + d];
    }
    __builtin_amdgcn_sched_barrier(0);
    __syncthreads();
#pragma unroll
    for (int i = 0; i < 16; ++i) {
      const int t = tq * 16 + i;
      const float z = bf2f(rz[i]);
      const float f = lb + (1.f - lb) * sigm(z);
      kk[i] = 1.f - f;
      c += __logf(fmaxf(f, 1e-30f));
      cl[i] = c;
      qv[i] = bf2f(rq[i]);
      VT[d * 72 + t] = rvv[i];
    }
    tot[tq * 128 + d] = c;
    __syncthreads();
    const float t0 = tot[d], t1 = tot[128 + d], t2 = tot[256 + d], t3 = tot[384 + d];
    const float off = (tq == 0) ? 0.f : (tq == 1) ? t0 : (tq == 2) ? (t0 + t1) : (t0 + t1 + t2);
    const float mref = t0 + t1, last = t0 + t1 + t2 + t3;
    u16* qib = (u16*)(p.ws + OFF_QIB) + (size_t)dir * RR * 512;
#pragma unroll
    for (int i = 0; i < 16; ++i) {
      const int t = tq * 16 + i;
      const int row = rowb + (dir ? 63 - t : t);
      const float cum = off + cl[i];
      qib[(size_t)row * 512 + h * 128 + d] = f2bf(qv[i] * __expf(cum));
      Qm[t * 136 + d] = f2bf(qv[i] * __expf(fminf(cum - mref, 80.f)));
      Km[t * 136 + d] = f2bf(kk[i] * __expf(fminf(mref - cum, 80.f)));
      KlT[d * 72 + t] = f2bf(kk[i] * __expf(last - cum));
    }
    if (tq == 0) ((float*)(p.ws + OFF_DEC))[((size_t)(dir * 192 + gc) * 4 + h) * 128 + d] = __expf(last);
    __syncthreads();
    {
      const int mt = w >> 1;
#pragma unroll
      for (int nn = 0; nn < 2; ++nn) {
        const int nt = (w & 1) * 2 + nn;
        f32x4 a = f32x4{0.f, 0.f, 0.f, 0.f};
#pragma unroll
        for (int ks = 0; ks < 4; ++ks) {
          const bf16x8 mf = *(const bf16x8*)(Qm + (mt * 16 + fr) * 136 + ks * 32 + fq * 8);
          const bf16x8 nf = *(const bf16x8*)(Km + (nt * 16 + fr) * 136 + ks * 32 + fq * 8);
          a = __builtin_amdgcn_mfma_f32_16x16x32_bf16(nf, mf, a, 0, 0, 0);
        }
        const int t = mt * 16 + fr, s0 = nt * 16 + fq * 4;
        const float p0 = (s0 + 0 <= t) ? a[0] : 0.f, p1 = (s0 + 1 <= t) ? a[1] : 0.f;
        const float p2 = (s0 + 2 <= t) ? a[2] : 0.f, p3 = (s0 + 3 <= t) ? a[3] : 0.f;
        *(uint2*)(Pm + t * 72 + s0) = uint2{pack2(p0, p1), pack2(p2, p3)};
      }
    }
    __syncthreads();
    {
      const int mt = w & 3, ntb = (w >> 2) * 4;
      u16* og = (u16*)(p.ws + OFF_OHG) + (size_t)dir * RR * 512;
      const int t = mt * 16 + fr;
      const int row = rowb + (dir ? 63 - t : t);
      bf16x8 mf0 = *(const bf16x8*)(Pm + t * 72 + fq * 8), mf1 = *(const bf16x8*)(Pm + t * 72 + 32 + fq * 8);
#pragma unroll
      for (int nn = 0; nn < 4; ++nn) {
        const int nt = ntb + nn;
        f32x4 a = f32x4{0.f, 0.f, 0.f, 0.f};
        const bf16x8 nf0 = *(const bf16x8*)(VT + (nt * 16 + fr) * 72 + fq * 8), nf1 = *(const bf16x8*)(VT + (nt * 16 + fr) * 72 + 32 + fq * 8);
        a = __builtin_amdgcn_mfma_f32_16x16x32_bf16(nf0, mf0, a, 0, 0, 0);
        a = __builtin_amdgcn_mfma_f32_16x16x32_bf16(nf1, mf1, a, 0, 0, 0);
        *(uint2*)(og + (size_t)row * 512 + h * 128 + nt * 16 + fq * 4) = uint2{pack2(a[0], a[1]), pack2(a[2], a[3])};
      }
    }
    {
      const int mt = w;
      u16* ds = (u16*)(p.ws + OFF_DS) + ((size_t)(dir * 192 + gc) * 4 + h) * 16384;
      const bf16x8 mf0 = *(const bf16x8*)(VT + (mt * 16 + fr) * 72 + fq * 8), mf1 = *(const bf16x8*)(VT + (mt * 16 + fr) * 72 + 32 + fq * 8);
#pragma unroll
      for (int nt = 0; nt < 8; ++nt) {
        f32x4 a = f32x4{0.f, 0.f, 0.f, 0.f};
        const bf16x8 nf0 = *(const bf16x8*)(KlT + (nt * 16 + fr) * 72 + fq * 8), nf1 = *(const bf16x8*)(KlT + (nt * 16 + fr) * 72 + 32 + fq * 8);
        a = __builtin_amdgcn_mfma_f32_16x16x32_bf16(nf0, mf0, a, 0, 0, 0);
        a = __builtin_amdgcn_mfma_f32_16x16x32_bf16(nf1, mf1, a, 0, 0, 0);
        *(uint2*)(ds + (size_t)(mt * 16 + fr) * 128 + nt * 16 + fq * 4) = uint2{pack2(a[0], a[1]), pack2(a[2], a[3])};
      }
    }
  }
  __syncthreads();
}

__device__ __forceinline__ void hgrnB2_item(const Params& p, int layer, int gc, int hp) {
  const int tid = otid(), lane = tid & 63, w = tid >> 6, fr = lane & 15, fq = lane >> 4;
  const int mt = w & 3, h = hp * 2 + (w >> 2);
  const size_t row = (size_t)gc * 64 + mt * 16 + fr;
  const u16* qib = (const u16*)(p.ws + OFF_QIB);
  const u16* dsb = (const u16*)(p.ws + OFF_DS);
  f32x4 acc[8];
#pragma unroll
  for (int nt = 0; nt < 8; ++nt) acc[nt] = f32x4{0.f, 0.f, 0.f, 0.f};
#pragma unroll
  for (int dir = 0; dir < 2; ++dir) {
    const u16* qrow = qib + ((size_t)dir * RR + row) * 512 + h * 128 + fq * 8;
    const u16* sT = dsb + ((size_t)(dir * 192 + gc) * 4 + h) * 16384 + (size_t)fr * 128 + fq * 8;
    bf16x8 mf[4];
#pragma unroll
    for (int ks = 0; ks < 4; ++ks) mf[ks] = *(const bf16x8*)(qrow + ks * 32);
    bf16x8 nfa[8], nfb[8];
#pragma unroll
    for (int nt = 0; nt < 8; ++nt) nfa[nt] = *(const bf16x8*)(sT + (size_t)nt * 16 * 128);
#pragma unroll
    for (int nt = 0; nt < 8; ++nt) nfb[nt] = *(const bf16x8*)(sT + (size_t)nt * 16 * 128 + 32);
    __builtin_amdgcn_sched_barrier(0);
#pragma unroll
    for (int nt = 0; nt < 8; ++nt) acc[nt] = __builtin_amdgcn_mfma_f32_16x16x32_bf16(nfa[nt], mf[0], acc[nt], 0, 0, 0);
#pragma unroll
    for (int nt = 0; nt < 8; ++nt) nfa[nt] = *(const bf16x8*)(sT + (size_t)nt * 16 * 128 + 64);
    __builtin_amdgcn_sched_barrier(0);
#pragma unroll
    for (int nt = 0; nt < 8; ++nt) acc[nt] = __builtin_amdgcn_mfma_f32_16x16x32_bf16(nfb[nt], mf[1], acc[nt], 0, 0, 0);
#pragma unroll
    for (int nt = 0; nt < 8; ++nt) nfb[nt] = *(const bf16x8*)(sT + (size_t)nt * 16 * 128 + 96);
    __builtin_amdgcn_sched_barrier(0);
#pragma unroll
    for (int nt = 0; nt < 8; ++nt) acc[nt] = __builtin_amdgcn_mfma_f32_16x16x32_bf16(nfa[nt], mf[2], acc[nt], 0, 0, 0);
#pragma unroll
    for (int nt = 0; nt < 8; ++nt) acc[nt] = __builtin_amdgcn_mfma_f32_16x16x32_bf16(nfb[nt], mf[3], acc[nt], 0, 0, 0);
  }
  const u16* og0 = (const u16*)(p.ws + OFF_OHG) + row * 512 + h * 128 + fq * 4;
  const u16* og1 = og0 + (size_t)RR * 512;
  float ss = 0.f;
  uint2 o0s[8], o1s[8];
#pragma unroll
  for (int nt = 0; nt < 8; ++nt) { o0s[nt] = *(const uint2*)(og0 + nt * 16); o1s[nt] = *(const uint2*)(og1 + nt * 16); }
  __builtin_amdgcn_sched_barrier(0);
#pragma unroll
  for (int nt = 0; nt < 8; ++nt) {
    const f32x4 a0 = f32x4{bflo(o0s[nt].x), bfhi(o0s[nt].x), bflo(o0s[nt].y), bfhi(o0s[nt].y)};
    const f32x4 a1 = f32x4{bflo(o1s[nt].x), bfhi(o1s[nt].x), bflo(o1s[nt].y), bfhi(o1s[nt].y)};
    acc[nt] += a0 + a1;
    ss += acc[nt][0] * acc[nt][0] + acc[nt][1] * acc[nt][1] + acc[nt][2] * acc[nt][2] + acc[nt][3] * acc[nt][3];
  }
  ss = rowsum4(ss);
  const float inv = rsqrtf(ss * (1.f / 128.f) + 1e-6f);
  const u16* proj = (const u16*)(p.ws + OFF_PROJ);
  u16* Z = (u16*)(p.ws + OFF_Z);
  float4 gns[8]; uint2 ggs[8];
#pragma unroll
  for (int nt = 0; nt < 8; ++nt) {
    const int e = nt * 16 + fq * 4;
    gns[nt] = *(const float4*)(p.in[28] + (size_t)layer * 128 + e);
    ggs[nt] = *(const uint2*)(proj + row * PS + C_GD + h * 128 + e);
  }
  __builtin_amdgcn_sched_barrier(0);
#pragma unroll
  for (int nt = 0; nt < 8; ++nt) {
    const int e = nt * 16 + fq * 4;
    const float4 gn = gns[nt];
    const uint2 gg = ggs[nt];
    const float r0 = acc[nt][0] * inv * gn.x * silu(bflo(gg.x)), r1 = acc[nt][1] * inv * gn.y * silu(bfhi(gg.x));
    const float r2 = acc[nt][2] * inv * gn.z * silu(bflo(gg.y)), r3 = acc[nt][3] * inv * gn.w * silu(bfhi(gg.y));
    *(uint2*)(Z + row * ZS + Z_D + h * 128 + e) = uint2{pack2(r0, r1), pack2(r2, r3)};
  }
}

__device__ __forceinline__ void attn_item(const Params& p, int unit, int lu, int seq, int head, int qb, u16* smem) {
  const int tid = otid(), lane = tid & 63, wid = tid >> 6, fr = lane & 15, fq = lane >> 4;
  const bool ctx = (unit == 0);
  const int L = ctx ? 256 : 4096;
  const int nkeys = ctx ? 256 : NKMAX;
  const int hkv = head >> 2;
  const int qrow0 = lu * 4096 + seq * L + qb * 256 + wid * 32;
  const u16* Qb = (const u16*)(p.ws + OFF_QB);
  const u16* Kg = (const u16*)(p.ws + OFF_KB) + ((size_t)lu * NKMAX + (ctx ? seq * 256 : 0)) * 256 + hkv * 128;
  const u16* Vg = (const u16*)(p.ws + OFF_VT) + (size_t)lu * 256 * NKMAX + (ctx ? (size_t)(seq * 2 + hkv) * 128 * 256 : (size_t)hkv * 128 * NKMAX);
  bf16x8 qf[2][4];
#pragma unroll
  for (int nt = 0; nt < 2; ++nt)
#pragma unroll
    for (int ks = 0; ks < 4; ++ks)
      qf[nt][ks] = *(const bf16x8*)(Qb + (size_t)(qrow0 + nt * 16 + fr) * 1024 + head * 128 + ks * 32 + fq * 8);
  f32x4 OT[8][2];
#pragma unroll
  for (int a = 0; a < 8; ++a) { OT[a][0] = f32x4{0.f, 0.f, 0.f, 0.f}; OT[a][1] = f32x4{0.f, 0.f, 0.f, 0.f}; }
  float mrun[2] = {0.f, 0.f}, lrun[2] = {0.f, 0.f};
  const int ntile = nkeys >> 6;
  uint4 rk0, rk1, rv0, rv1;
  const int kkey = tid >> 4, kdc = (tid & 15) * 8;
  const int vd = tid >> 3, vkc = (tid & 7) * 8;
#define ATT_ISSUE(kt_) do { \
    const u16* kp_ = Kg + (size_t)((kt_) * 64 + kkey) * 256 + kdc; \
    const u16* vp_ = Vg + (size_t)vd * nkeys + (kt_) * 64 + vkc; \
    rk0 = *(const uint4*)(kp_); rk1 = *(const uint4*)(kp_ + 32 * 256); \
    rv0 = *(const uint4*)(vp_); rv1 = *(const uint4*)(vp_ + (size_t)64 * nkeys); \
  } while (0)
#define ATT_WRITE(buf_) do { u16* ks_ = smem + (buf_) * 17920; u16* vs_ = ks_ + 64 * 136; \
    *(uint4*)(ks_ + (kkey) * 136 + kdc) = rk0; *(uint4*)(ks_ + (kkey + 32) * 136 + kdc) = rk1; \
    *(uint4*)(vs_ + (vd) * 72 + vkc) = rv0; *(uint4*)(vs_ + (vd + 64) * 72 + vkc) = rv1; } while (0)
  ATT_ISSUE(0);
  __syncthreads();
  ATT_WRITE(0);
  if (ntile > 1) ATT_ISSUE(1);
  __syncthreads();
  for (int kt = 0; kt < ntile; ++kt) {
    const u16* Ks = smem + (kt & 1) * 17920;
    const u16* Vs = Ks + 64 * 136;
    f32x4 ST[4][2];
#pragma unroll
    for (int a = 0; a < 4; ++a) {
      ST[a][0] = f32x4{-mrun[0], -mrun[0], -mrun[0], -mrun[0]};
      ST[a][1] = f32x4{-mrun[1], -mrun[1], -mrun[1], -mrun[1]};
    }
#pragma unroll
    for (int ks = 0; ks < 4; ++ks) {
#pragma unroll
      for (int mt = 0; mt < 4; ++mt) {
        const bf16x8 kf = *(const bf16x8*)(Ks + (mt * 16 + fr) * 136 + ks * 32 + fq * 8);
        ST[mt][0] = __builtin_amdgcn_mfma_f32_16x16x32_bf16(kf, qf[0][ks], ST[mt][0], 0, 0, 0);
        ST[mt][1] = __builtin_amdgcn_mfma_f32_16x16x32_bf16(kf, qf[1][ks], ST[mt][1], 0, 0, 0);
      }
    }
    u32x4 pfu[2][2];
#pragma unroll
    for (int nt = 0; nt < 2; ++nt) {
      float mx = fmaxf(fmaxf(ST[0][nt][0], ST[0][nt][1]), fmaxf(ST[0][nt][2], ST[0][nt][3]));
#pragma unroll
      for (int mt = 1; mt < 4; ++mt) mx = fmaxf(mx, fmaxf(fmaxf(ST[mt][nt][0], ST[mt][nt][1]), fmaxf(ST[mt][nt][2], ST[mt][nt][3])));
      mx = rowmax4(mx);
      const bool need = (kt == 0) || (mx > 8.f);
      if (__any(need)) {
        const float delta = need ? mx : 0.f;
        const float alpha = __builtin_amdgcn_exp2f(-delta);
        mrun[nt] += delta;
        lrun[nt] *= alpha;
#pragma unroll
        for (int mt = 0; mt < 4; ++mt) ST[mt][nt] -= delta;
#pragma unroll
        for (int dt = 0; dt < 8; ++dt) OT[dt][nt] *= alpha;
      }
      float ps = 0.f;
#pragma unroll
      for (int mt = 0; mt < 4; ++mt) {
        const float p0 = __builtin_amdgcn_exp2f(ST[mt][nt][0]), p1 = __builtin_amdgcn_exp2f(ST[mt][nt][1]);
        const float p2 = __builtin_amdgcn_exp2f(ST[mt][nt][2]), p3 = __builtin_amdgcn_exp2f(ST[mt][nt][3]);
        ps += (p0 + p1) + (p2 + p3);
        pfu[nt][mt >> 1][(mt & 1) * 2 + 0] = pack2(p0, p1);
        pfu[nt][mt >> 1][(mt & 1) * 2 + 1] = pack2(p2, p3);
      }
      lrun[nt] += ps;
    }
    if (kt + 1 < ntile) ATT_WRITE((kt + 1) & 1);
    if (kt + 2 < ntile) ATT_ISSUE(kt + 2);
#pragma unroll
    for (int kk = 0; kk < 2; ++kk) {
      const bf16x8 pf0 = __builtin_bit_cast(bf16x8, pfu[0][kk]), pf1 = __builtin_bit_cast(bf16x8, pfu[1][kk]);
#pragma unroll
      for (int dt = 0; dt < 8; ++dt) {
        const u16* vrow = Vs + (dt * 16 + fr) * 72 + kk * 32 + fq * 4;
        const uint2 v0 = *(const uint2*)(vrow), v1 = *(const uint2*)(vrow + 16);
        const bf16x8 vf = __builtin_bit_cast(bf16x8, (u32x4){v0.x, v0.y, v1.x, v1.y});
        OT[dt][0] = __builtin_amdgcn_mfma_f32_16x16x32_bf16(vf, pf0, OT[dt][0], 0, 0, 0);
        OT[dt][1] = __builtin_amdgcn_mfma_f32_16x16x32_bf16(vf, pf1, OT[dt][1], 0, 0, 0);
      }
    }
    __syncthreads();
  }
  const u16* proj = (const u16*)(p.ws + OFF_PROJ);
  u16* Z = (u16*)(p.ws + OFF_Z);
#pragma unroll
  for (int nt = 0; nt < 2; ++nt) {
    const float lt = rowsum4(lrun[nt]);
    const float inv = 1.f / lt;
    const size_t row = (size_t)(qrow0 + nt * 16 + fr);
    uint2 ggs[8];
#pragma unroll
    for (int dt = 0; dt < 8; ++dt) ggs[dt] = *(const uint2*)(proj + row * PS + C_GC + head * 128 + dt * 16 + fq * 4);
    __builtin_amdgcn_sched_barrier(0);
#pragma unroll
    for (int dt = 0; dt < 8; ++dt) {
      const int dd = head * 128 + dt * 16 + fq * 4;
      const uint2 gg = ggs[dt];
      const float o0 = OT[dt][nt][0] * inv * silu(bflo(gg.x)), o1 = OT[dt][nt][1] * inv * silu(bfhi(gg.x));
      const float o2 = OT[dt][nt][2] * inv * silu(bflo(gg.y)), o3 = OT[dt][nt][3] * inv * silu(bfhi(gg.y));
      *(uint2*)(Z + row * ZS + Z_C + dd) = uint2{pack2(o0, o1), pack2(o2, o3)};
    }
  }
  __syncthreads();
}

__global__ void __launch_bounds__(512) mega(Params p) {
  __shared__ __attribute__((aligned(1024))) char shm[131072];
  u16* smem = (u16*)shm;
  __shared__ int s_slot;
  __shared__ uint4 xb_words;
  if (threadIdx.x == 0) xb_words = make_uint4(0u, 0u, 0u, 0u);
  cg::grid_group grid = cg::this_grid();
  const int bid = blockIdx.x, nb = gridDim.x;
#define PHASE_IDS const int tid = otid(), lane = tid & 63, wid = tid >> 6; const size_t gtid = (size_t)bid * 512 + tid; const int gwave = bid * 8 + wid; const int gi = wid >> 2; u16* smg = smem + gi * 20480; (void)gi; (void)smg; (void)lane; (void)gtid; (void)gwave
  const size_t gthreads = (size_t)nb * 512;
  const int nwaves = nb * 8;
  char* ws = p.ws;
#define WinT ((u16*)(p.ws + OFF_WINT))
#define WpA ((u16*)(p.ws + OFF_WPA))
#define WpB ((u16*)(p.ws + OFF_WPB))
#define WpC ((u16*)(p.ws + OFF_WPC))
#define WpD ((u16*)(p.ws + OFF_WPD))
#define WoutT ((u16*)(p.ws + OFF_WOUT))
#define GluT ((u16*)(p.ws + OFF_GLU))
#define FWt ((u16*)(p.ws + OFF_FWT))
#define DftL ((u16*)(p.ws + OFF_DFTL))
#define DftS ((u16*)(p.ws + OFF_DFTS))
#define modp ((float*)(p.ws + OFF_MODP))
#define modb ((float*)(p.ws + OFF_MOD))
#define ctr ((int*)(p.ws + OFF_CTR))
#define hbuf ((u16*)(p.ws + OFF_H))
#define proj ((u16*)(p.ws + OFF_PROJ))
#define Z ((u16*)(p.ws + OFF_Z))
#define PQt ((u16*)(p.ws + OFF_PQT))
#define ys ((u16*)(p.ws + OFF_YS))
#define yb ((u16*)(p.ws + OFF_YB))
#define Qb ((u16*)(p.ws + OFF_QB))
#define Kb ((u16*)(p.ws + OFF_KB))
#define Vt ((u16*)(p.ws + OFF_VT))
#define mixed ((u16*)(p.ws + OFF_MIXED))
#define outb ((u16*)(p.ws + OFF_OUTB))

  {
  PHASE_IDS;
  if (bid == 0) for (int i = tid; i < 1024; i += 512) ctr[i] = 0;
  if (bid == 0) for (int i = tid; i < 4096; i += 512) ((unsigned*)(p.ws + OFF_XBAR))[i] = 0u;
  for (int l = 0; l < 2; ++l) {
    conv_transpose(p.in[13] + (size_t)l * 2048 * 15360, 2048, 15360, WinT + (size_t)l * 15360 * 2048, (float*)smem);
    conv_transpose(p.in[29] + (size_t)l * 512 * 2048, 512, 2048, WpA + (size_t)l * 2048 * 512, (float*)smem);
    conv_transpose(p.in[30] + (size_t)l * 512 * 2048, 512, 2048, WpB + (size_t)l * 2048 * 512, (float*)smem);
    conv_transpose(p.in[31] + (size_t)l * 1024 * 2048, 1024, 2048, WpC + (size_t)l * 2048 * 1024, (float*)smem);
    conv_transpose(p.in[32] + (size_t)l * 512 * 2048, 512, 2048, WpD + (size_t)l * 2048 * 512, (float*)smem);
    conv_transpose(p.in[33] + (size_t)l * 2048 * 2048, 2048, 2048, WoutT + (size_t)l * 2048 * 2048, (float*)smem);
    conv_transpose(p.in[23] + (size_t)l * 512 * 512, 512, 512, GluT + (size_t)l * 512 * 512, (float*)smem);
  }
  for (size_t idx = gtid; idx < (size_t)2048 * 4096; idx += gthreads) {
    const int k = (int)(idx >> 12), l = (int)(idx & 4095);
    const int m = (k * l) & 4095;
    const float a = (float)m * (6.283185307179586f / 4096.f);
    DftL[(size_t)k * 8192 + l] = f2bf(__cosf(a) * (1.f / 64.f));
    DftL[(size_t)k * 8192 + 4096 + l] = f2bf(-__sinf(a) * (1.f / 64.f));
  }
  for (size_t idx = gtid; idx < (size_t)256 * 256; idx += gthreads) {
    const int k = (int)(idx >> 8), l = (int)(idx & 255);
    const int m = (k * l) & 255;
    const float a = (float)m * (6.283185307179586f / 256.f);
    DftS[(size_t)k * 512 + l] = f2bf(__cosf(a) * (1.f / 16.f));
    DftS[(size_t)k * 512 + 256 + l] = f2bf(-__sinf(a) * (1.f / 16.f));
  }
  for (size_t idx = gtid; idx < (size_t)2 * 4 * 256 * 128; idx += gthreads) {
    const int c = (int)(idx & 127), n = (int)((idx >> 7) & 255), lg = (int)(idx >> 15);
    const float* w = p.in[14] + (size_t)lg * 128 * 128 + (n & 127);
    float acc = 0.f;
    for (int m = 0; m < 128; ++m) {
      const float a = (float)((m * c) & 127) * (6.283185307179586f / 128.f);
      const float tr = (n < 128) ? __cosf(a) : __sinf(a);
      acc += tr * w[(size_t)m * 128];
    }
    FWt[idx] = f2bf(acc * 0.08838834764831845f);
  }
  for (int it = bid; it < 384; it += nb) {
    const int layer = it / 192, rem = it % 192, cb = rem >> 4, kc = rem & 15;
    float* sc = (float*)smem;
    __syncthreads();
    for (int idx = tid; idx < 9 * 128; idx += 512) {
      const int u = idx >> 7, k = idx & 127;
      const float cv = (u == 0) ? p.in[8][kc * 128 + k] : p.in[2][(size_t)(u - 1) * 2048 + kc * 128 + k];
      sc[idx] = silu(cv);
    }
    __syncthreads();
    const int col = cb * 512 + tid;
    float a9[9];
#pragma unroll
    for (int u = 0; u < 9; ++u) a9[u] = 0.f;
    const float* wm = p.in[11] + ((size_t)layer * 2048 + kc * 128) * 6144 + col;
    for (int k0 = 0; k0 < 128; k0 += 16) {
      float wv[16];
#pragma unroll
      for (int j = 0; j < 16; ++j) wv[j] = wm[(size_t)(k0 + j) * 6144];
      __builtin_amdgcn_sched_barrier(0);
#pragma unroll
      for (int j = 0; j < 16; ++j)
#pragma unroll
        for (int u = 0; u < 9; ++u) a9[u] += sc[u * 128 + k0 + j] * wv[j];
    }
#pragma unroll
    for (int u = 0; u < 9; ++u) modp[((size_t)(kc * 2 + layer) * 9 + u) * 6144 + col] = a9[u];
  }
  }
  grid.sync();
  XcdBarrier xb = xcd_barrier_post((unsigned*)(p.ws + OFF_XBAR), (volatile LAS unsigned*)&xb_words);
  {
  PHASE_IDS;
  for (size_t idx = gtid; idx < (size_t)2 * 9 * 6144; idx += gthreads) {
    const int col = (int)(idx % 6144), lu_ = (int)(idx / 6144), layer = lu_ / 9;
    float a = p.in[12][(size_t)layer * 6144 + col];
    for (int kc = 0; kc < 16; ++kc) a += modp[(size_t)kc * 2 * 9 * 6144 + idx];
    modb[idx] = a;
  }
  }
  grid.sync();

  unsigned* gcnt = (unsigned*)(ctr + 1000);
  unsigned gtarget = 0u;
  for (int rd = 0; rd < 3; ++rd) {
    for (int layer = 0; layer < 2; ++layer) {
      if (layer == 0) {
      PHASE_IDS;
      for (int row = gwave; row < RR; row += nwaves) {
        const int lu = row >> 12, t = row & 4095, unit = rd * 3 + lu;
        const float4* x4 = (const float4*)x_in_row(p, layer, unit, t);
        const float* md = modb + (size_t)(layer * 9 + unit) * 6144;
        float4 v[8];
        float ss = 0.f;
#pragma unroll
        for (int i = 0; i < 8; ++i) { v[i] = x4[lane + i * 64]; ss += v[i].x * v[i].x + v[i].y * v[i].y + v[i].z * v[i].z + v[i].w * v[i].w; }
        ss = wave_sum(ss);
        const float inv = rsqrtf(ss * (1.f / 2048.f) + 1e-6f);
#pragma unroll
        for (int i = 0; i < 8; ++i) {
          const int col = (lane + i * 64) * 4;
          const float4 g = *(const float4*)(p.in[9] + (size_t)layer * 2048 + col);
          const float4 sh = *(const float4*)(md + col), sc = *(const float4*)(md + 2048 + col);
          const float h0 = v[i].x * inv * g.x * (1.f + sc.x) + sh.x, h1 = v[i].y * inv * g.y * (1.f + sc.y) + sh.y;
          const float h2 = v[i].z * inv * g.z * (1.f + sc.z) + sh.z, h3 = v[i].w * inv * g.w * (1.f + sc.w) + sh.w;
          *(uint2*)(hbuf + (size_t)row * 2048 + col) = uint2{pack2(h0, h1), pack2(h2, h3)};
        }
      }
      xcd_barrier(xb);
      }
      {
        const u16* W = WinT + (size_t)layer * 15360 * 2048;
        const int nfull = (48 * 60 / nb) * nb;
        const int ntl = nfull / nb;
        f32x4 acc[8][4];
#pragma unroll
        for (int a_ = 0; a_ < 8; ++a_)
#pragma unroll
          for (int b_ = 0; b_ < 4; ++b_) acc[a_][b_] = f32x4{0.f, 0.f, 0.f, 0.f};
        if (ntl > 0)
        gemm256_stream<256>(ntl,
          [&](int s_, const u16*& A_, int& lda_, const u16*& B_, int& ldb_, int& nk_) {
            const int t = bid + s_ * nb, mt = t % 48, nt = t / 48;
            A_ = hbuf + (size_t)mt * 256 * 2048; lda_ = 2048; B_ = W + (size_t)nt * 256 * 2048; ldb_ = 2048; nk_ = 32;
          },
          [&](int s_, f32x4 (&ac)[8][4]) {
            const int t = bid + s_ * nb, mt = t % 48, nt = t / 48;
            EPI256(256);
            const bool mg = (nt * 256 >= C_M);
#pragma unroll
            for (int m = 0; m < 8; ++m)
#pragma unroll
              for (int n = 0; n < 4; ++n) {
                f32x4 a = ac[m][n];
                if (mg) { a[0] = sigm(a[0]); a[1] = sigm(a[1]); a[2] = sigm(a[2]); a[3] = sigm(a[3]); }
                *(uint2*)(proj + (size_t)(mt * 256 + E256_ROW(m)) * PS + nt * 256 + E256_COL(n)) = uint2{pack2(a[0], a[1]), pack2(a[2], a[3])};
              }
          }, acc, shm);
        const int nhalf = (48 * 60 - nfull) * 2;
        if (bid < nhalf) {
          f32x4 acc2[4][4];
          ACC_ZERO(acc2);
          const int t = nfull + (bid >> 1), mt = t % 48, nt = t / 48, hf = bid & 1;
          gemm256_stream<128>(1,
            [&](int s_, const u16*& A_, int& lda_, const u16*& B_, int& ldb_, int& nk_) {
              A_ = hbuf + (size_t)mt * 256 * 2048; lda_ = 2048; B_ = W + ((size_t)nt * 256 + hf * 128) * 2048; ldb_ = 2048; nk_ = 32;
            },
            [&](int s_, f32x4 (&ac)[4][4]) {
              EPI256(128);
              const bool mg = (nt * 256 >= C_M);
#pragma unroll
              for (int m = 0; m < 4; ++m)
#pragma unroll
                for (int n = 0; n < 4; ++n) {
                  f32x4 a = ac[m][n];
                  if (mg) { a[0] = sigm(a[0]); a[1] = sigm(a[1]); a[2] = sigm(a[2]); a[3] = sigm(a[3]); }
                  *(uint2*)(proj + (size_t)(mt * 256 + E256_ROW(m)) * PS + nt * 256 + hf * 128 + E256_COL(n)) = uint2{pack2(a[0], a[1]), pack2(a[2], a[3])};
                }
            }, acc2, shm);
        }
      }
      xcd_barrier(xb);
      {
        PHASE_IDS;
        int* cq3 = ctr + 64 + (rd * 2 + layer);
        while (true) {
        const int it = grab(cq3, &s_slot);
        if (it >= 1752) break;
        {
        int layer_o = layer, rd_o = rd;
        asm volatile("" : "+s"(layer_o), "+s"(rd_o));
        const int layer = layer_o, rd = rd_o;
        if (it >= 1368) {
          const int t2 = it - 1368;
          const int t = t2 * 2 + gi;
          const int mt = t % 96, gn = t / 96, g = gn >> 1, nh = gn & 1;
          f32x4 acc[4][4];
          ACC_ZERO(acc);
          gemm_tile(proj + (size_t)mt * 128 * PS + C_UA + g * 128, PS, FWt + ((size_t)(layer * 4 + g) * 256 + nh * 128) * 128, 128, 128, acc, smg);
          EPI_IDX;
#pragma unroll
          for (int mi = 0; mi < 4; ++mi) {
            const int row = mt * 128 + EPI_ROW(mi);
            const int lu = row >> 12, tt = row & 4095, unit = rd * 3 + lu;
            const bool ctx = (unit == 0);
            const int L = ctx ? 256 : 4096;
            const int seq = ctx ? (tt >> 8) : 0, l = ctx ? (tt & 255) : tt;
            u16* base = PQt + (size_t)lu * 4096 * 1024 + (size_t)seq * 512 * 2 * L + (size_t)nh * L + l;
#pragma unroll
            for (int ni = 0; ni < 4; ++ni) {
              const int dcol = EPI_COL(ni);
#pragma unroll
              for (int j = 0; j < 4; ++j) base[(size_t)(g * 128 + dcol + j) * 2 * L] = f2bf(acc[ni][mi][j]);
            }
          }
        }
        if (it < 384) s5_item(p, layer, rd, it, 1, smem);
        else if (it < 1152) hgrnA_item(p, layer, (it - 384) >> 2, (it - 384) & 3, shm);
        const float qscale = 0.08838834764831845f * 1.4426950408889634f;
        if (it >= 1152 && it < 1344)
        for (int rr = 0; rr < 8; ++rr) {
          const int row = (it - 1152) * 64 + wid * 8 + rr;
          const int lu = row >> 12, t = row & 4095, unit = rd * 3 + lu;
          const bool ctx = (unit == 0);
          const int seq = ctx ? (t >> 8) : 0, l = ctx ? (t & 255) : t;
          const u16* pr = proj + (size_t)row * PS;
          const int a = lane >> 5, i = lane & 31;
          float cs = 1.f, sn = 0.f;
          if (!ctx) {
            const float pos = (float)(a == 0 ? (l >> 6) : (l & 63));
            const float ang = pos * __expf(-(float)i * (9.210340371976184f / 32.f));
            cs = __cosf(ang); sn = __sinf(ang);
          }
          u16 rx1[10], rx2[10], rvx[4];
#pragma unroll
          for (int hh = 0; hh < 10; ++hh) {
            const int cb = (hh < 8) ? (C_QC + hh * 128) : (C_KC + (hh - 8) * 128);
            rx1[hh] = pr[cb + a * 64 + i]; rx2[hh] = pr[cb + a * 64 + 32 + i];
          }
#pragma unroll
          for (int e = 0; e < 4; ++e) rvx[e] = pr[C_VC + lane + e * 64];
          __builtin_amdgcn_sched_barrier(0);
#pragma unroll
          for (int hh = 0; hh < 10; ++hh) {
            const float x1 = bf2f(rx1[hh]), x2 = bf2f(rx2[hh]);
            const float ssq = wave_sum(x1 * x1 + x2 * x2);
            const float inv = rsqrtf(ssq * (1.f / 128.f) + 1e-6f);
            const float* gn = (hh < 8) ? (p.in[25] + layer * 128) : (p.in[26] + layer * 128);
            float y1 = x1 * inv * gn[a * 64 + i], y2 = x2 * inv * gn[a * 64 + 32 + i];
            if (hh >= 8 && ctx) {
              const size_t oi = OCK + ((((size_t)seq * 2 + layer) * 256 + l) * 2 + (hh - 8)) * 128 + a * 64 + i;
              p.out[oi] = y1; p.out[oi + 32] = y2;
            }
            const float r1 = y1 * cs - y2 * sn, r2 = y2 * cs + y1 * sn;
            if (hh < 8) {
              Qb[(size_t)row * 1024 + hh * 128 + a * 64 + i] = f2bf(r1 * qscale);
              Qb[(size_t)row * 1024 + hh * 128 + a * 64 + 32 + i] = f2bf(r2 * qscale);
            } else {
              const size_t kr = (size_t)lu * NKMAX + (ctx ? (seq * 256 + l) : l);
              Kb[kr * 256 + (hh - 8) * 128 + a * 64 + i] = f2bf(r1);
              Kb[kr * 256 + (hh - 8) * 128 + a * 64 + 32 + i] = f2bf(r2);
            }
          }
#pragma unroll
          for (int e = 0; e < 4; ++e) {
            const int idx = lane + e * 64, hkv = idx >> 7, dd = idx & 127;
            const u16 vv = rvx[e];
            if (ctx) {
              p.out[OCV + ((((size_t)seq * 2 + layer) * 256 + l) * 2 + hkv) * 128 + dd] = bf2f(vv);
              Vt[(size_t)lu * 256 * NKMAX + ((size_t)(seq * 2 + hkv) * 128 + dd) * 256 + l] = vv;
            } else {
              Vt[(size_t)lu * 256 * NKMAX + ((size_t)hkv * 128 + dd) * NKMAX + l] = vv;
            }
          }
        }
        if (it >= 1344 && it < 1368) {
          float kv[8][4], vvv[8][4];
#pragma unroll
          for (int rr = 0; rr < 8; ++rr) {
            const int r = (it - 1344) * 64 + wid * 8 + rr;
            const int lu = r >> 9, j = r & 511, unit = rd * 3 + lu;
            const size_t ci = (((size_t)((unit > 0 ? unit : 1) - 1) * 2 + layer) * 512 + j) * 256;
#pragma unroll
            for (int e = 0; e < 4; ++e) { kv[rr][e] = p.in[3][ci + lane + e * 64]; vvv[rr][e] = p.in[4][ci + lane + e * 64]; }
          }
          __builtin_amdgcn_sched_barrier(0);
#pragma unroll
          for (int rr = 0; rr < 8; ++rr) {
            const int r = (it - 1344) * 64 + wid * 8 + rr;
            const int lu = r >> 9, j = r & 511, unit = rd * 3 + lu;
            if (unit != 0) {
#pragma unroll
              for (int e = 0; e < 4; ++e) {
                const int idx = lane + e * 64;
                Kb[((size_t)lu * NKMAX + 4096 + j) * 256 + idx] = f2bf(kv[rr][e]);
                Vt[(size_t)lu * 256 * NKMAX + (size_t)idx * NKMAX + 4096 + j] = f2bf(vvv[rr][e]);
              }
            }
          }
        }
        }
        }
      }
      xcd_barrier(xb);
      {
        const int nl = (rd == 0) ? 2 : 3, ncx = (rd == 0) ? 1 : 0, lu0 = ncx;
        const int n_hl = nl * 32, n_at = nl * 128, n_df = 0, n_hc = nl * 8, n_s5 = 384, n_ac = ncx * 128, n_dc = ncx * 32;
        const int e0 = n_hl, e1 = e0 + n_at, e2 = e1 + n_df, e3 = e2 + n_hc, e4 = e3 + n_s5, e5 = e4 + n_ac, e6 = e5 + n_dc;
        const int nb1 = ncx * 1024 + nl * 64;
        int* cq = ctr + (rd * 2 + layer);
        while (true) {
          int it = grab(cq, &s_slot);
          if (it >= e6 + nb1) break;
          if (it < nb1) {
            const int lu = (ncx && it < 1024) ? 0 : (ncx ? 1 + ((it - 1024) >> 6) : (it >> 6));
            const int ii = (ncx && it < 1024) ? it : (ncx ? ((it - 1024) & 63) : (it & 63));
            const int unit = rd * 3 + lu;
            const bool ctx = (unit == 0);
            const int nch = ctx ? 4 : 64;
            u16* dsb = (u16*)(p.ws + OFF_DS);
            const float* dec = (const float*)(p.ws + OFF_DEC);
            const size_t idx = (size_t)ii * 512 + otid();
            {
              const int dq = (int)(idx & 31), e = (int)((idx >> 5) & 127), h = (int)((idx >> 12) & 3), dir = (int)((idx >> 14) & 1), seq = (int)(idx >> 15);
              const int c0 = lu * 64 + seq * nch;
              float S0 = 0.f, S1 = 0.f, S2 = 0.f, S3 = 0.f;
              if (!ctx) {
                const float* st = p.in[7] + (((((size_t)(unit - 1) * 2 + layer) * 2 + dir) * 4 + h) * 128 + dq * 4) * 128 + e;
                S0 = st[0]; S1 = st[128]; S2 = st[256]; S3 = st[384];
              }
              for (int cc = 0; cc < nch; cc += 4) {
                uint2 tv[4]; float4 dc[4]; u16* ptr[4];
#pragma unroll
                for (int k = 0; k < 4; ++k) {
                  const int gc = dir ? (c0 + nch - 1 - cc - k) : (c0 + cc + k);
                  const size_t bi_ = (size_t)(dir * 192 + gc) * 4 + h;
                  ptr[k] = dsb + (bi_ * 128 + e) * 128 + dq * 4;
                  tv[k] = *(const uint2*)ptr[k];
                  dc[k] = *(const float4*)(dec + bi_ * 128 + dq * 4);
                }
#pragma unroll
                for (int k = 0; k < 4; ++k) {
                  *(uint2*)ptr[k] = uint2{pack2(S0, S1), pack2(S2, S3)};
                  S0 = dc[k].x * S0 + bflo(tv[k].x); S1 = dc[k].y * S1 + bfhi(tv[k].x);
                  S2 = dc[k].z * S2 + bflo(tv[k].y); S3 = dc[k].w * S3 + bfhi(tv[k].y);
                }
              }
              if (ctx) {
                float* o = p.out + OHG + (((((size_t)seq * 2 + layer) * 2 + dir) * 4 + h) * 128 + dq * 4) * 128 + e;
                o[0] = S0; o[128] = S1; o[256] = S2; o[384] = S3;
              }
            }
            continue;
          }
          it -= nb1;
          if (it < e0) {
            const int lu = lu0 + it / 32, r = it % 32, mt = r & 7, nt = r >> 3;
            f32x4 acc[4][4], accA[4][4];
            ACC_ZERO(acc);
            ACC_ZERO(accA);
            const u16* Bm = PQt + (size_t)lu * 4096 * 1024 + (size_t)nt * 128 * 8192;
            gemm256_stream<128>(2,
              [&](int s_, const u16*& A_, int& lda_, const u16*& B_, int& ldb_, int& nk_) {
                A_ = DftL + (size_t)mt * 256 * 8192 + s_ * 4096; lda_ = 8192; B_ = Bm + s_ * 4096; ldb_ = 8192; nk_ = 64;
              },
              [&](int s_, f32x4 (&ac)[4][4]) {
                if (s_ == 0) {
#pragma unroll
                  for (int m = 0; m < 4; ++m)
#pragma unroll
                    for (int n = 0; n < 4; ++n) accA[m][n] = ac[m][n];
                } else {
                  EPI256(128);
                  uint2 gs_[4][4];
#pragma unroll
                  for (int m = 0; m < 4; ++m)
#pragma unroll
                    for (int n = 0; n < 4; ++n)
                      gs_[m][n] = *(const uint2*)(proj + ((size_t)lu * 4096 + mt * 256 + E256_ROW(m)) * PS + C_GA + nt * 128 + E256_COL(n));
                  __builtin_amdgcn_sched_barrier(0);
#pragma unroll
                  for (int m = 0; m < 4; ++m)
#pragma unroll
                    for (int n = 0; n < 4; ++n) {
                      const size_t row = (size_t)lu * 4096 + mt * 256 + E256_ROW(m);
                      const int col = nt * 128 + E256_COL(n);
                      const uint2 gg = gs_[m][n];
                      const f32x4 a = accA[m][n] + ac[m][n];
                      *(uint2*)(Z + row * ZS + Z_A + col) = uint2{pack2(a[0] * silu(bflo(gg.x)), a[1] * silu(bfhi(gg.x))),
                                                                   pack2(a[2] * silu(bflo(gg.y)), a[3] * silu(bfhi(gg.y)))};
                    }
                  __builtin_amdgcn_sched_barrier(0);
#pragma unroll
                  for (int m = 0; m < 4; ++m)
#pragma unroll
                    for (int n = 0; n < 4; ++n)
                      gs_[m][n] = *(const uint2*)(proj + ((size_t)lu * 4096 + ((4096 - (mt * 256 + E256_ROW(m))) & 4095)) * PS + C_GA + nt * 128 + E256_COL(n));
                  __builtin_amdgcn_sched_barrier(0);
#pragma unroll
                  for (int m = 0; m < 4; ++m)
#pragma unroll
                    for (int n = 0; n < 4; ++n) {
                      const int k = mt * 256 + E256_ROW(m);
                      const int col = nt * 128 + E256_COL(n);
                      if (k > 0) {
                        const size_t row = (size_t)lu * 4096 + (4096 - k);
                        const uint2 gg = gs_[m][n];
                        const f32x4 a = accA[m][n] - ac[m][n];
                        *(uint2*)(Z + row * ZS + Z_A + col) = uint2{pack2(a[0] * silu(bflo(gg.x)), a[1] * silu(bfhi(gg.x))),
                                                                     pack2(a[2] * silu(bflo(gg.y)), a[3] * silu(bfhi(gg.y)))};
                      }
                    }
                }
              }, acc, shm);
          } else if (it < e1) {
            const int i2 = it - e0, lu = lu0 + i2 / 128, r = i2 % 128;
            attn_item(p, rd * 3 + lu, lu, 0, r >> 4, r & 15, smem);
          } else if (it < e3) {
            const int i2 = it - e2, lu = lu0 + (i2 >> 3), chg = i2 & 7;
            const int tid_ = otid(), lane_ = tid_ & 63, w_ = tid_ >> 6;
            for (int c = 0; c < 8; ++c) {
              const int ch = chg * 64 + w_ * 8 + c;
              const u16* src = PQt + (size_t)lu * 4096 * 1024 + (size_t)ch * 8192 + lane_ * 8;
              uint4 v[8];
#pragma unroll
              for (int i = 0; i < 8; ++i) v[i] = *(const uint4*)(src + i * 512);
              __builtin_amdgcn_sched_barrier(0);
              float a = 0.f;
#pragma unroll
              for (int i = 0; i < 8; ++i)
                a += (bflo(v[i].x) - bfhi(v[i].x)) + (bflo(v[i].y) - bfhi(v[i].y)) + (bflo(v[i].z) - bfhi(v[i].z)) + (bflo(v[i].w) - bfhi(v[i].w));
              a = wave_sum(a) * (1.f / 64.f);
              if (lane_ == 0) {
                const size_t row = (size_t)lu * 4096 + 2048;
                Z[row * ZS + Z_A + ch] = f2bf(a * silu(bf2f(proj[row * PS + C_GA + ch])));
              }
            }
          } else if (it < e4) {
            s5_item(p, layer, rd, it - e3, 2, smem);
          } else if (it < e5) {
            const int i2 = it - e4, seq = i2 >> 3, r = i2 & 7;
            attn_item(p, 0, 0, seq, r, 0, smem);
          } else {
            const int i2 = it - e5;
            for (int q = 0; q < 2; ++q) {
              const int tix = i2 * 4 + q * 2 + (int)(otid() >> 8), seq = tix >> 3, r = tix & 7, mt = r & 1, nt = r >> 1;
              f32x4 acc[4][4];
              ACC_ZERO(acc);
              gemm_tile(DftS + (size_t)mt * 128 * 512, 512, PQt + (size_t)seq * 512 * 512 + (size_t)nt * 128 * 512, 512, 512, acc, smem + (otid() >> 8) * 20480);
              EPI_IDX;
#pragma unroll
              for (int ni = 0; ni < 4; ++ni)
#pragma unroll
                for (int mi = 0; mi < 4; ++mi) {
                  const size_t row = (size_t)seq * 256 + mt * 128 + EPI_ROW(mi);
                  const int col = nt * 128 + EPI_COL(ni);
                  const uint2 gg = *(const uint2*)(proj + row * PS + C_GA + col);
                  const f32x4 a = acc[ni][mi];
                  *(uint2*)(Z + row * ZS + Z_A + col) = uint2{pack2(a[0] * silu(bflo(gg.x)), a[1] * silu(bfhi(gg.x))),
                                                               pack2(a[2] * silu(bflo(gg.y)), a[3] * silu(bfhi(gg.y)))};
                }
            }
          }
        }
      }
      xcd_barrier(xb);
      {
      PHASE_IDS;
      for (int row = gwave; row < RR; row += nwaves) {
        const u16* pr = proj + (size_t)row * PS;
        {
          const int c0 = lane * 8;
          const uint4 ya_ = *(const uint4*)(ys + (size_t)row * 512 + c0), yb_ = *(const uint4*)(ys + (size_t)(RR + row) * 512 + c0);
          const float4 a0 = float4{bflo(ya_.x), bfhi(ya_.x), bflo(ya_.y), bfhi(ya_.y)}, a1 = float4{bflo(ya_.z), bfhi(ya_.z), bflo(ya_.w), bfhi(ya_.w)};
          const float4 b0 = float4{bflo(yb_.x), bfhi(yb_.x), bflo(yb_.y), bfhi(yb_.y)}, b1 = float4{bflo(yb_.z), bfhi(yb_.z), bflo(yb_.w), bfhi(yb_.w)};
          const float4 d0 = *(const float4*)(p.in[22] + (size_t)layer * 512 + c0), d1 = *(const float4*)(p.in[22] + (size_t)layer * 512 + c0 + 4);
          const uint4 uu = *(const uint4*)(pr + C_UB + c0);
          uint4 o;
          o.x = pack2(gelu_t(a0.x + b0.x + d0.x * bflo(uu.x)), gelu_t(a0.y + b0.y + d0.y * bfhi(uu.x)));
          o.y = pack2(gelu_t(a0.z + b0.z + d0.z * bflo(uu.y)), gelu_t(a0.w + b0.w + d0.w * bfhi(uu.y)));
          o.z = pack2(gelu_t(a1.x + b1.x + d1.x * bflo(uu.z)), gelu_t(a1.y + b1.y + d1.y * bfhi(uu.z)));
          o.w = pack2(gelu_t(a1.z + b1.z + d1.z * bflo(uu.w)), gelu_t(a1.w + b1.w + d1.w * bfhi(uu.w)));
          *(uint4*)(yb + (size_t)row * 512 + c0) = o;
        }
      }
      for (int it = bid; it < 384; it += nb) hgrnB2_item(p, layer, it >> 1, it & 1);
      }
      xcd_barrier(xb);
      for (int t2 = bid; t2 < 96 * 2; t2 += nb) {
        const int gi6 = (int)(otid() >> 8);
        const int t = t2 * 2 + gi6;
        const int mt = t % 96, nt = t / 96;
        f32x4 acc[4][4];
        ACC_ZERO(acc);
        gemm_tile(yb + (size_t)mt * 128 * 512, 512, GluT + (size_t)layer * 512 * 512 + (size_t)nt * 128 * 512, 512, 512, acc, smem + gi6 * 20480);
        EPI_IDX;
        float4 bbs[4]; uint2 yys[4][4], ggs[4][4];
#pragma unroll
        for (int ni = 0; ni < 4; ++ni) {
          bbs[ni] = *(const float4*)(p.in[24] + (size_t)layer * 512 + nt * 128 + EPI_COL(ni));
#pragma unroll
          for (int mi = 0; mi < 4; ++mi) {
            const size_t row = (size_t)mt * 128 + EPI_ROW(mi);
            const int col = nt * 128 + EPI_COL(ni);
            yys[ni][mi] = *(const uint2*)(yb + row * 512 + col);
            ggs[ni][mi] = *(const uint2*)(proj + row * PS + C_GB + col);
          }
        }
        __builtin_amdgcn_sched_barrier(0);
#pragma unroll
        for (int ni = 0; ni < 4; ++ni)
#pragma unroll
          for (int mi = 0; mi < 4; ++mi) {
            const size_t row = (size_t)mt * 128 + EPI_ROW(mi);
            const int col = nt * 128 + EPI_COL(ni);
            const float4 bb = bbs[ni];
            const uint2 yy = yys[ni][mi];
            const uint2 gg = ggs[ni][mi];
            const f32x4 a = acc[ni][mi];
            const float r0 = bflo(yy.x) * sigm(a[0] + bb.x) * silu(bflo(gg.x)), r1 = bfhi(yy.x) * sigm(a[1] + bb.y) * silu(bfhi(gg.x));
            const float r2 = bflo(yy.y) * sigm(a[2] + bb.z) * silu(bflo(gg.y)), r3 = bfhi(yy.y) * sigm(a[3] + bb.w) * silu(bfhi(gg.y));
            *(uint2*)(Z + row * ZS + Z_B + col) = uint2{pack2(r0, r1), pack2(r2, r3)};
          }
      }
      xcd_barrier(xb);
      {
        const int ntl = (48 * 16 - bid + nb - 1) / nb;
        f32x4 mix[4][4], acc[4][4];
        ACC_ZERO(mix);
        ACC_ZERO(acc);
        if (ntl > 0)
        gemm256_stream<128>(ntl * 4,
          [&](int s_, const u16*& A_, int& lda_, const u16*& B_, int& ldb_, int& nk_) {
            const int t = bid + (s_ >> 2) * nb, mt = t % 48, nt = t / 48, j = s_ & 3;
            const int Kj = (j == 2) ? 1024 : 512;
            const int zo = (j == 0) ? Z_A : (j == 1) ? Z_B : (j == 2) ? Z_C : Z_D;
            const u16* Wj = (j == 0) ? WpA : (j == 1) ? WpB : (j == 2) ? WpC : WpD;
            A_ = Z + (size_t)mt * 256 * ZS + zo; lda_ = ZS; B_ = Wj + (size_t)layer * 2048 * Kj + (size_t)nt * 128 * Kj; ldb_ = Kj; nk_ = Kj >> 6;
          },
          [&](int s_, f32x4 (&ac)[4][4]) {
            const int t = bid + (s_ >> 2) * nb, mt = t % 48, nt = t / 48, j = s_ & 3;
            EPI256(128);
            uint2 ggs[4][4];
#pragma unroll
            for (int m = 0; m < 4; ++m)
#pragma unroll
              for (int n = 0; n < 4; ++n)
                ggs[m][n] = *(const uint2*)(proj + ((size_t)mt * 256 + E256_ROW(m)) * PS + C_M + j * 2048 + nt * 128 + E256_COL(n));
            __builtin_amdgcn_sched_barrier(0);
#pragma unroll
            for (int m = 0; m < 4; ++m)
#pragma unroll
              for (int n = 0; n < 4; ++n) {
                const size_t row = (size_t)mt * 256 + E256_ROW(m);
                const int col = nt * 128 + E256_COL(n);
                const uint2 gg = ggs[m][n];
                mix[m][n][0] += bflo(gg.x) * ac[m][n][0];
                mix[m][n][1] += bfhi(gg.x) * ac[m][n][1];
                mix[m][n][2] += bflo(gg.y) * ac[m][n][2];
                mix[m][n][3] += bfhi(gg.y) * ac[m][n][3];
                if (j == 3) {
                  *(uint2*)(mixed + row * 2048 + col) = uint2{pack2(mix[m][n][0], mix[m][n][1]), pack2(mix[m][n][2], mix[m][n][3])};
                  mix[m][n] = f32x4{0.f, 0.f, 0.f, 0.f};
                }
              }
          }, acc, shm);
      }
      xcd_barrier(xb);
      {
        const int ntl = (48 * 16 - bid + nb - 1) / nb;
        f32x4 acc[4][4];
        ACC_ZERO(acc);
        if (ntl > 0)
        gemm256_stream<128>(ntl,
          [&](int s_, const u16*& A_, int& lda_, const u16*& B_, int& ldb_, int& nk_) {
            const int t = bid + s_ * nb, mt = t % 48, nt = t / 48;
            A_ = mixed + (size_t)mt * 256 * 2048; lda_ = 2048; B_ = WoutT + (size_t)layer * 2048 * 2048 + (size_t)nt * 128 * 2048; ldb_ = 2048; nk_ = 32;
          },
          [&](int s_, f32x4 (&ac)[4][4]) {
            const int t = bid + s_ * nb, mt = t % 48, nt = t / 48;
            EPI256(128);
#pragma unroll
            for (int m = 0; m < 4; ++m)
#pragma unroll
              for (int n = 0; n < 4; ++n) {
                const size_t row = (size_t)mt * 256 + E256_ROW(m);
                const int col = nt * 128 + E256_COL(n);
                *(uint2*)(outb + row * 2048 + col) = uint2{pack2(ac[m][n][0], ac[m][n][1]), pack2(ac[m][n][2], ac[m][n][3])};
              }
          }, acc, shm);
      }
      xcd_barrier(xb);
      {
      PHASE_IDS;
      for (int row = gwave; row < RR; row += nwaves) {
        const int lu = row >> 12, t = row & 4095, unit = rd * 3 + lu;
        const float4* x4 = (const float4*)x_in_row(p, layer, unit, t);
        float4* y4 = (float4*)y_out_row(p, unit, t);
        const float* md = modb + (size_t)(layer * 9 + unit) * 6144 + 4096;
        const uint2* o4 = (const uint2*)(outb + (size_t)row * 2048);
        float4 v[8];
        float ss = 0.f;
#pragma unroll
        for (int i = 0; i < 8; ++i) {
          const uint2 ov = o4[lane + i * 64];
          v[i] = float4{bflo(ov.x), bfhi(ov.x), bflo(ov.y), bfhi(ov.y)};
          ss += v[i].x * v[i].x + v[i].y * v[i].y + v[i].z * v[i].z + v[i].w * v[i].w;
        }
        ss = wave_sum(ss);
        const float inv = rsqrtf(ss * (1.f / 2048.f) + 1e-6f);
        float4 xvs[8];
#pragma unroll
        for (int i = 0; i < 8; ++i) xvs[i] = x4[lane + i * 64];
        __builtin_amdgcn_sched_barrier(0);
#pragma unroll
        for (int i = 0; i < 8; ++i) {
          const int col = (lane + i * 64) * 4;
          const float4 g = *(const float4*)(p.in[10] + (size_t)layer * 2048 + col);
          const float4 gt = *(const float4*)(md + col);
          const float4 xv = xvs[i];
          float4 y;
          y.x = xv.x + gt.x * (v[i].x * inv * g.x); y.y = xv.y + gt.y * (v[i].y * inv * g.y);
          y.z = xv.z + gt.z * (v[i].z * inv * g.z); y.w = xv.w + gt.w * (v[i].w * inv * g.w);
          y4[lane + i * 64] = y;
          v[i] = y;
        }
        if (layer == 0) {
          float s2 = 0.f;
#pragma unroll
          for (int i = 0; i < 8; ++i) s2 += v[i].x * v[i].x + v[i].y * v[i].y + v[i].z * v[i].z + v[i].w * v[i].w;
          s2 = wave_sum(s2);
          const float inv2 = rsqrtf(s2 * (1.f / 2048.f) + 1e-6f);
          const float* md1 = modb + (size_t)(9 + unit) * 6144;
#pragma unroll
          for (int i = 0; i < 8; ++i) {
            const int col = (lane + i * 64) * 4;
            const float4 g = *(const float4*)(p.in[9] + 2048 + col);
            const float4 sh = *(const float4*)(md1 + col), sc = *(const float4*)(md1 + 2048 + col);
            const float h0 = v[i].x * inv2 * g.x * (1.f + sc.x) + sh.x, h1 = v[i].y * inv2 * g.y * (1.f + sc.y) + sh.y;
            const float h2 = v[i].z * inv2 * g.z * (1.f + sc.z) + sh.z, h3 = v[i].w * inv2 * g.w * (1.f + sc.w) + sh.w;
            *(uint2*)(hbuf + (size_t)row * 2048 + col) = uint2{pack2(h0, h1), pack2(h2, h3)};
          }
        }
      }
      }
      xcd_barrier(xb);
    }
  }
}

extern "C" void kernel_launch(void* const* d_in, const int* in_sizes, int n_in,
                              void* d_out, int out_size, void* d_ws, size_t ws_size,
                              hipStream_t stream) {
  static int grid_blocks = 0;
  if (!grid_blocks) {
    int dev = 0, cus = 0, per_cu = 0;
    (void)hipGetDevice(&dev);
    (void)hipDeviceGetAttribute(&cus, hipDeviceAttributeMultiprocessorCount, dev);
    (void)hipOccupancyMaxActiveBlocksPerMultiprocessor(&per_cu, mega, 512, 0);
    if (per_cu > 1) per_cu = 1;
    if (per_cu < 1) per_cu = 1;
    grid_blocks = cus * per_cu;
  }
  if (ws_size < OFF_END) { fprintf(stderr, "workspace too small: %zu < %zu\n", ws_size, (size_t)OFF_END); return; }
  Params p{};
  for (int i = 0; i < 34; ++i) p.in[i] = (const float*)d_in[i];
  p.out = (float*)d_out;
  p.ws = (char*)d_ws;
  void* args[] = {&p};
  hipError_t e = hipLaunchCooperativeKernel((void*)mega, dim3(grid_blocks), dim3(512), args, 0, stream);
  if (e != hipSuccess) fprintf(stderr, "cooperative launch failed: %s (grid %d)\n", hipGetErrorString(e), grid_blocks);
}
```
